# Optimizing an MI355X kernel written in HIP

```python
import math
import jax, jax.numpy as jnp
from jax import lax
import numpy as np

D_MODEL = 1024
BATCH = 16
SEQ = 2048
DEPTH = 2

N_MEM = 256
EPS = 1e-6
MIX_WIDTH = D_MODEL
M_HEADS = 4
M_WIDTH = MIX_WIDTH // 2
M_DV = M_WIDTH // M_HEADS
M_DK = M_DV // 2
CONV_K = 4
CHUNK = 64
F_BIAS_LO = 3.0
F_BIAS_HI = 6.0
A_HEADS = 4
A_DV = 128
A_WIDTH = A_HEADS * A_DV
Q_LORA = 256
KV_LORA = 128
NOPE_DIM = 128
ROPE_DIM = 64
A_QK = NOPE_DIM + ROPE_DIM
ROPE_THETA = 10000.0
Q_BLOCK = 128
IN_SPLITS = (M_WIDTH, M_WIDTH, M_WIDTH, M_HEADS, M_HEADS, Q_LORA, KV_LORA, ROPE_DIM)
IN_COLS = sum(IN_SPLITS)
X_HEADS = 4
X_HD = 128
X_WIDTH = X_HEADS * X_HD
D_FF = 4 * D_MODEL

kernel_name = "hybrid_mlstm_mla_memxattn_block"


def rmsnorm(x, g):
    xf = x.astype(jnp.float32)
    y = xf * lax.rsqrt(jnp.mean(xf * xf, axis=-1, keepdims=True) + EPS)
    return (y * g.astype(jnp.float32)).astype(x.dtype)


def rope_tables(positions):
    inv = 1.0 / (ROPE_THETA ** (jnp.arange(0, ROPE_DIM, 2, dtype=jnp.float32) / ROPE_DIM))
    ang = positions.astype(jnp.float32)[..., None] * inv
    return jnp.cos(ang), jnp.sin(ang)


def apply_rope(x, cos, sin):
    extra = x.ndim - 3
    shp = cos.shape[:2] + (1,) * extra + cos.shape[-1:]
    c = cos.reshape(shp)
    s = sin.reshape(shp)
    x1, x2 = jnp.split(x.astype(jnp.float32), 2, axis=-1)
    return jnp.concatenate([x1 * c - x2 * s, x2 * c + x1 * s], axis=-1).astype(x.dtype)


def causal_dwconv(u, w, b):
    C = u.shape[-1]
    y = lax.conv_general_dilated(
        u, w[:, None, :].astype(u.dtype), window_strides=(1,),
        padding=[(CONV_K - 1, 0)], dimension_numbers=('NWC', 'WIO', 'NWC'),
        feature_group_count=C)
    return y + b


def mlstm_chunkwise(q, k, v, ig, fg):
    f32 = jnp.float32
    Bn, H, S, DK = q.shape
    DV = v.shape[-1]
    L = CHUNK
    NC = S // L
    qc = (q.astype(f32) * (DK ** -0.5)).reshape(Bn, H, NC, L, DK)
    kc = k.astype(f32).reshape(Bn, H, NC, L, DK)
    vc = v.astype(f32).reshape(Bn, H, NC, L, DV)
    logf = jax.nn.log_sigmoid(fg.astype(f32)).reshape(Bn, H, NC, L)
    ic = ig.astype(f32).reshape(Bn, H, NC, L)
    b = jnp.cumsum(logf, axis=-1)
    b_tot = b[..., -1]

    a = b_tot[..., None] - b + ic
    m_loc = jnp.max(a, axis=-1)
    wa = jnp.exp(a - m_loc[..., None])
    C_loc = jnp.einsum('bhcl,bhcld,bhcle->bhcde', wa, kc, vc)
    n_loc = jnp.einsum('bhcl,bhcld->bhcd', wa, kc)

    def step(carry, inp):
        C, n, m = carry
        bt, ml, Cl, nl = inp
        m_new = jnp.maximum(bt + m, ml)
        s_old = jnp.exp(bt + m - m_new)
        s_loc = jnp.exp(ml - m_new)
        C_new = s_old[..., None, None] * C + s_loc[..., None, None] * Cl
        n_new = s_old[..., None] * n + s_loc[..., None] * nl
        return (C_new, n_new, m_new), (C, n, m)

    init = (jnp.zeros((Bn, H, DK, DV), f32), jnp.zeros((Bn, H, DK), f32), jnp.zeros((Bn, H), f32))
    xs = (jnp.moveaxis(b_tot, 2, 0), jnp.moveaxis(m_loc, 2, 0),
          jnp.moveaxis(C_loc, 2, 0), jnp.moveaxis(n_loc, 2, 0))
    _, (C_prev, n_prev, m_prev) = lax.scan(step, init, xs)
    C_prev = jnp.moveaxis(C_prev, 0, 2)
    n_prev = jnp.moveaxis(n_prev, 0, 2)
    m_prev = jnp.moveaxis(m_prev, 0, 2)

    causal = jnp.tril(jnp.ones((L, L), dtype=bool))
    Dlog = b[..., :, None] - b[..., None, :] + ic[..., None, :]
    Dlog = jnp.where(causal, Dlog, -jnp.inf)
    inter_log = b + m_prev[..., None]
    m_j = jnp.maximum(inter_log, jnp.max(Dlog, axis=-1))
    Dw = jnp.exp(Dlog - m_j[..., None])
    qk = jnp.einsum('bhcjd,bhcsd->bhcjs', qc, kc) * Dw
    s_inter = jnp.exp(inter_log - m_j)
    num = (s_inter[..., None] * jnp.einsum('bhcjd,bhcde->bhcje', qc, C_prev)
           + jnp.einsum('bhcjs,bhcse->bhcje', qk, vc))
    den = s_inter * jnp.einsum('bhcjd,bhcd->bhcj', qc, n_prev) + jnp.sum(qk, axis=-1)
    h = num / jnp.maximum(jnp.abs(den), jnp.exp(-m_j))[..., None]
    return h.reshape(Bn, H, S, DV).astype(v.dtype)


def causal_block_attention(q, k, v):
    Bn, H, S, Dq = q.shape
    Dv = v.shape[-1]
    nb = S // Q_BLOCK
    scale = Dq ** -0.5
    qb = q.reshape(Bn, H, nb, Q_BLOCK, Dq).transpose(2, 0, 1, 3, 4)
    kpos = jnp.arange(S)

    def one_block(args):
        qi, bi = args
        s = jnp.einsum('bhqd,bhkd->bhqk', qi, k).astype(jnp.float32) * scale
        qpos = bi * Q_BLOCK + jnp.arange(Q_BLOCK)
        s = jnp.where(kpos[None, :] <= qpos[:, None], s, -jnp.inf)
        p = jax.nn.softmax(s, axis=-1)
        return jnp.einsum('bhqk,bhkd->bhqd', p.astype(v.dtype), v)

    out = lax.map(one_block, (qb, jnp.arange(nb)))
    return out.transpose(1, 2, 0, 3, 4).reshape(Bn, H, S, Dv)


def parallel_mixer(h, cos, sin, w_in, conv_w, conv_b, wq_m, wk_m, b_igate, b_fgate, m_out_g,
                   cq_norm_g, ckv_norm_g, w_uq, w_ukv, qk_norm_q, qk_norm_k, a_out_g, w_out):
    Bn, S, _ = h.shape
    proj = h @ w_in
    idx = np.cumsum(IN_SPLITS)[:-1].tolist()
    u, v_m, o_pre, i_pre, f_pre, c_q, c_kv, k_r = jnp.split(proj, idx, axis=-1)

    u_c = jax.nn.silu(causal_dwconv(u, conv_w, conv_b))
    u_h = u_c.reshape(Bn, S, M_HEADS, M_DV)
    q_m = jnp.einsum('bshd,hde->bhse', u_h, wq_m)
    k_m = jnp.einsum('bshd,hde->bhse', u_h, wk_m)
    v_h = v_m.reshape(Bn, S, M_HEADS, M_DV).transpose(0, 2, 1, 3)
    ig = (i_pre + b_igate).transpose(0, 2, 1)
    fg = (f_pre + b_fgate).transpose(0, 2, 1)
    hm = mlstm_chunkwise(q_m, k_m, v_h, ig, fg)
    hm = rmsnorm(hm.transpose(0, 2, 1, 3), m_out_g)
    y_m = jax.nn.sigmoid(o_pre) * hm.reshape(Bn, S, M_WIDTH)

    q_a = (rmsnorm(c_q, cq_norm_g) @ w_uq).reshape(Bn, S, A_HEADS, A_QK)
    kv = (rmsnorm(c_kv, ckv_norm_g) @ w_ukv).reshape(Bn, S, A_HEADS, NOPE_DIM + A_DV)
    k_nope, v_a = jnp.split(kv, [NOPE_DIM], axis=-1)
    q_nope = rmsnorm(q_a[..., :NOPE_DIM], qk_norm_q[:NOPE_DIM])
    q_rope = apply_rope(rmsnorm(q_a[..., NOPE_DIM:], qk_norm_q[NOPE_DIM:]), cos, sin)
    k_nope = rmsnorm(k_nope, qk_norm_k[:NOPE_DIM])
    k_rope = apply_rope(rmsnorm(k_r, qk_norm_k[NOPE_DIM:]), cos, sin)
    k_rope = jnp.broadcast_to(k_rope[:, :, None, :], (Bn, S, A_HEADS, ROPE_DIM))
    q_full = jnp.concatenate([q_nope, q_rope], axis=-1).transpose(0, 2, 1, 3)
    k_full = jnp.concatenate([k_nope, k_rope], axis=-1).transpose(0, 2, 1, 3)
    o_a = causal_block_attention(q_full, k_full, v_a.transpose(0, 2, 1, 3))
    y_a = rmsnorm(o_a.transpose(0, 2, 1, 3), a_out_g).reshape(Bn, S, A_WIDTH)

    return jnp.concatenate([y_m, y_a], axis=-1) @ w_out


def memory_cross_attention(h, mem_n, wq_x, wkv_x, xq_norm_g, xk_norm_g, wo_x):
    Bn, S, _ = h.shape
    Nm = mem_n.shape[1]
    q = rmsnorm((h @ wq_x).reshape(Bn, S, X_HEADS, X_HD), xq_norm_g)
    kv = (mem_n @ wkv_x).reshape(Bn, Nm, 2, X_HEADS, X_HD)
    k = rmsnorm(kv[:, :, 0], xk_norm_g)
    v = kv[:, :, 1]
    s = jnp.einsum('bshd,bnhd->bhsn', q, k).astype(jnp.float32) * (X_HD ** -0.5)
    p = jax.nn.softmax(s, axis=-1)
    o = jnp.einsum('bhsn,bnhd->bshd', p.astype(v.dtype), v).reshape(Bn, S, X_WIDTH)
    return o @ wo_x


def setup_inputs(seed: int = 0) -> dict:
    key = jax.random.key(seed)
    ks = jax.random.split(key, 32)
    f32 = jnp.float32
    nrm = lambda k, shp, scale: jax.random.normal(k, shp, f32) * scale
    gain = lambda k, shp: 1.0 + 0.02 * jax.random.normal(k, shp, f32)
    Ld = DEPTH
    x = jax.random.normal(ks[0], (BATCH, SEQ, D_MODEL), f32)
    mem = jax.random.normal(ks[1], (BATCH, N_MEM, D_MODEL), f32)
    offset = jax.random.randint(ks[2], (BATCH, 1), 0, 1024, dtype=jnp.int32)
    positions = (offset + jnp.arange(SEQ, dtype=jnp.int32)[None, :]).astype(jnp.int32)
    b_f = (jnp.linspace(F_BIAS_LO, F_BIAS_HI, M_HEADS, dtype=f32)[None, :]
           + 0.1 * jax.random.normal(ks[10], (Ld, M_HEADS), f32))
    return {
        "x": x,
        "mem": mem,
        "positions": positions,
        "norm_mix_g": gain(ks[3], (Ld, D_MODEL)),
        "w_in": nrm(ks[4], (Ld, D_MODEL, IN_COLS), D_MODEL ** -0.5),
        "conv_w": nrm(ks[5], (Ld, CONV_K, M_WIDTH), CONV_K ** -0.5),
        "conv_b": nrm(ks[6], (Ld, M_WIDTH), 0.02),
        "wq_m": nrm(ks[7], (Ld, M_HEADS, M_DV, M_DK), M_DV ** -0.5),
        "wk_m": nrm(ks[8], (Ld, M_HEADS, M_DV, M_DK), M_DV ** -0.5),
        "b_igate": nrm(ks[9], (Ld, M_HEADS), 0.1),
        "b_fgate": b_f,
        "m_out_g": gain(ks[11], (Ld, M_HEADS, M_DV)),
        "cq_norm_g": gain(ks[12], (Ld, Q_LORA)),
        "ckv_norm_g": gain(ks[13], (Ld, KV_LORA)),
        "w_uq": nrm(ks[14], (Ld, Q_LORA, A_HEADS * A_QK), Q_LORA ** -0.5),
        "w_ukv": nrm(ks[15], (Ld, KV_LORA, A_HEADS * (NOPE_DIM + A_DV)), KV_LORA ** -0.5),
        "qk_norm_q": gain(ks[16], (Ld, A_QK)),
        "qk_norm_k": gain(ks[17], (Ld, A_QK)),
        "a_out_g": gain(ks[18], (Ld, A_HEADS, A_DV)),
        "w_out": nrm(ks[19], (Ld, MIX_WIDTH, D_MODEL), MIX_WIDTH ** -0.5),
        "norm_x_g": gain(ks[20], (Ld, D_MODEL)),
        "norm_mem_g": gain(ks[21], (Ld, D_MODEL)),
        "wq_x": nrm(ks[22], (Ld, D_MODEL, X_WIDTH), D_MODEL ** -0.5),
        "wkv_x": nrm(ks[23], (Ld, D_MODEL, 2 * X_WIDTH), D_MODEL ** -0.5),
        "xq_norm_g": gain(ks[24], (Ld, X_HD)),
        "xk_norm_g": gain(ks[25], (Ld, X_HD)),
        "wo_x": nrm(ks[26], (Ld, X_WIDTH, D_MODEL), X_WIDTH ** -0.5),
        "norm_ffn_g": gain(ks[27], (Ld, D_MODEL)),
        "w_ff1": nrm(ks[28], (Ld, D_MODEL, D_FF), D_MODEL ** -0.5),
        "w_ff2": nrm(ks[29], (Ld, D_FF, D_MODEL), D_FF ** -0.5),
    }


def reference(x, mem, positions, norm_mix_g, w_in, conv_w, conv_b, wq_m, wk_m, b_igate, b_fgate,
              m_out_g, cq_norm_g, ckv_norm_g, w_uq, w_ukv, qk_norm_q, qk_norm_k, a_out_g, w_out,
              norm_x_g, norm_mem_g, wq_x, wkv_x, xq_norm_g, xk_norm_g, wo_x,
              norm_ffn_g, w_ff1, w_ff2):
    cos, sin = rope_tables(positions)
    for l in range(DEPTH):
        h = rmsnorm(x, norm_mix_g[l])
        x = x + parallel_mixer(h, cos, sin, w_in[l], conv_w[l], conv_b[l], wq_m[l], wk_m[l],
                               b_igate[l], b_fgate[l], m_out_g[l], cq_norm_g[l], ckv_norm_g[l],
                               w_uq[l], w_ukv[l], qk_norm_q[l], qk_norm_k[l], a_out_g[l], w_out[l])
        h = rmsnorm(x, norm_x_g[l])
        mem_n = rmsnorm(mem, norm_mem_g[l])
        x = x + memory_cross_attention(h, mem_n, wq_x[l], wkv_x[l], xq_norm_g[l], xk_norm_g[l], wo_x[l])
        h = rmsnorm(x, norm_ffn_g[l])
        x = x + jnp.square(jax.nn.relu(h @ w_ff1[l])) @ w_ff2[l]
    return x
```

```cpp
#include <hip/hip_runtime.h>
#include <cstdio>
#include <cstdint>

#ifndef N_LAUNCHES
#define N_LAUNCHES 1
#endif

#define GAS __attribute__((address_space(1)))
#define LAS __attribute__((address_space(3)))
typedef unsigned short bf16_t;
typedef GAS unsigned gu32;
typedef float f32x4 __attribute__((ext_vector_type(4)));
typedef unsigned u32x4 __attribute__((ext_vector_type(4)));
typedef unsigned u32x2 __attribute__((ext_vector_type(2)));

constexpr int BATCH = 16, SEQ = 2048, D = 1024, T = BATCH * SEQ, NL = 2;
constexpr int NMEM = 256, TM = BATCH * NMEM;
constexpr int IN_COLS = 1992, NPROJ = 2048;
constexpr int PC_U = 0, PC_V = 512, PC_O = 1024, PC_CQ = 1536, PC_CKV = 1792, PC_KR = 1920, PC_G = 1984;
constexpr int DFF = 4096;
constexpr float EPS = 1e-6f;
constexpr float LOG2E = 1.4426950408889634f;
constexpr float QSCALE_A = 0.07216878364870322f * LOG2E;
constexpr float QSCALE_X = 0.08838834764831845f * LOG2E;

constexpr size_t MiB = 1u << 20;
constexpr size_t WS_CTL = 0, CTL_ZERO_BYTES = 1 * MiB;
constexpr size_t WS_W = 2 * MiB, W_LAYER = 26 * MiB;
constexpr size_t WO_IN = 0, WO_UQ = 4 * MiB, WO_UKV = 5 * MiB  , WO_QK = 5 * MiB + 512 * 1024  , WO_OUT = 6 * MiB, WO_QX = 8 * MiB,
                 WO_OX = 9 * MiB, WO_FF1 = 10 * MiB, WO_FF2 = 18 * MiB;
constexpr size_t WS_WKVX = WS_W + 2 * W_LAYER;
constexpr size_t WS_COS = 498 * MiB, WS_SIN = 502 * MiB;
constexpr size_t WS_XB = 64 * MiB;
constexpr size_t WS_XSSQ = 128 * MiB;
constexpr size_t WS_GATES = 130 * MiB;
constexpr size_t WS_RSCQ = 131 * MiB, WS_RSCKV = WS_RSCQ + 512 * 1024, WS_RSKR = 145 * MiB;
constexpr size_t WS_KR = 132 * MiB;
constexpr size_t WS_MEMB = 136 * MiB;
constexpr size_t WS_MEMSSQ = 144 * MiB;
constexpr size_t WS_KVX = 146 * MiB;
constexpr size_t WS_YMIX = 162 * MiB;
constexpr size_t WS_PROJ = 226 * MiB;
constexpr size_t WS_QKM = 354 * MiB;
constexpr size_t WS_QA = 386 * MiB;
constexpr size_t WS_KV = 434 * MiB;
constexpr size_t WS_END = 506 * MiB;
constexpr size_t WS_QX = 226 * MiB, WS_OX = 258 * MiB;
constexpr size_t WS_HFF = 226 * MiB;
constexpr int CW_BAR = 4096, CW_Q = 8192, CW_MIS = 12288;

__device__ __forceinline__ float bf2f(unsigned v) { return __uint_as_float(v << 16); }
__device__ __forceinline__ float bflo(unsigned w) { return __uint_as_float(w << 16); }
__device__ __forceinline__ float bfhi(unsigned w) { return __uint_as_float(w & 0xffff0000u); }
__device__ __forceinline__ unsigned f2bf(float f) { unsigned u = __float_as_uint(f); return (u + 0x7fffu + ((u >> 16) & 1u)) >> 16; }
__device__ __forceinline__ unsigned pk2(float lo, float hi) { return f2bf(lo) | (f2bf(hi) << 16); }
__device__ __forceinline__ float shx(float v, int mask, int lane) { return __int_as_float(__builtin_amdgcn_ds_bpermute((lane ^ mask) << 2, __float_as_int(v))); }
__device__ __forceinline__ float wave_sum(float v, int lane) {
#pragma unroll
    for (int o = 1; o < 64; o <<= 1) v += shx(v, o, lane);
    return v;
}
__device__ __forceinline__ float sigmoidf_(float x) { return __builtin_amdgcn_rcpf(1.0f + __builtin_amdgcn_exp2f(-1.4426950408889634f * x)); }

#define XB_TMO      128
#define XB_XCNT(j)  (256  + 64 * (j))
#define XB_XSUB(j)  (1280 + 64 * (j))
#define XB_XGEN(j)  (2304 + 64 * (j))
#define XB_TOP      3328
#define XB_TOPGEN   3392
#define XCD_BAR_WORDS 3456
#define XB_SPIN_CAP (1u << 18)
__device__ __forceinline__ unsigned xb_ld(unsigned* p)              { return __hip_atomic_load(p, __ATOMIC_RELAXED, __HIP_MEMORY_SCOPE_AGENT); }
__device__ __forceinline__ unsigned xb_add(unsigned* p, unsigned v) { return __hip_atomic_fetch_add(p, v, __ATOMIC_RELAXED, __HIP_MEMORY_SCOPE_AGENT); }
__device__ __forceinline__ unsigned xb_xcc_id() { return (unsigned)__builtin_amdgcn_s_getreg((3 << 11) | 20) & 0xFu; }
#define XB_SPIN(cond, bar) do { unsigned _sp = 0; while (cond) { __builtin_amdgcn_s_sleep(1); \
    if ((++_sp & 255u) == 0u) { if (xb_ld(&(bar)[XB_TMO])) break; if (_sp > XB_SPIN_CAP) { atomicAdd(&(bar)[XB_TMO], 1u); break; } } } } while (0)
struct XcdBarrier { unsigned* bar; unsigned x; volatile LAS unsigned* st; };
__device__ __forceinline__ XcdBarrier xcd_barrier_post(unsigned* bar, volatile LAS unsigned* st) {
    XcdBarrier b; b.bar = bar; b.x = xb_xcc_id(); b.st = st;
    if (threadIdx.x == 0) (void)xb_add(&bar[XB_XCNT(b.x)], 1u);
    return b;
}
__device__ __forceinline__ void xcd_barrier_complete(unsigned* bar, unsigned x, unsigned& nloc, unsigned& nx) {
    const unsigned G = gridDim.x * gridDim.y * gridDim.z;
    unsigned sum, cnt, mine, sp = 0u;
    for (;;) {
        sum = 0u; cnt = 0u; mine = 0u;
#pragma unroll
        for (unsigned j = 0; j < 16; ++j) { const unsigned c = xb_ld(&bar[XB_XCNT(j)]); sum += c; cnt += (c > 0u) ? 1u : 0u; mine = (j == x) ? c : mine; }
        if (sum == G) break;
        __builtin_amdgcn_s_sleep(1);
        if ((++sp & 255u) == 0u) { if (xb_ld(&bar[XB_TMO])) break; if (sp > XB_SPIN_CAP) { atomicAdd(&bar[XB_TMO], 1u); break; } }
    }
    nloc = mine > 0u ? mine : 1u; nx = cnt > 0u ? cnt : 1u;
}
__device__ __forceinline__ void xcd_barrier(const XcdBarrier& b, bool top) {
    asm volatile("s_waitcnt vmcnt(0)" ::: "memory");
    __syncthreads();
    if (threadIdx.x == 0) {
        unsigned* bar = b.bar; unsigned bx = b.x; asm volatile("" : "+s"(bar), "+s"(bx));
        __builtin_amdgcn_s_waitcnt(0);
        unsigned nloc = b.st[0], nx = b.st[1];
        if (nloc == 0u) { xcd_barrier_complete(bar, bx, nloc, nx); b.st[0] = nloc; b.st[1] = nx; }
        const unsigned old = xb_add(&bar[XB_XSUB(bx)], 1u);
        const unsigned gen = old / nloc;
        if (old + 1u == (gen + 1u) * nloc) {
            __builtin_amdgcn_fence(__ATOMIC_RELEASE, "agent");
            asm volatile("s_waitcnt vmcnt(0)" ::: "memory");
            if (top) {
                const unsigned og = xb_add(&bar[XB_TOP], 1u);
                const unsigned tg = og / nx;
                if (og + 1u == (tg + 1u) * nx) xb_add(&bar[XB_TOPGEN], 1u);
                else XB_SPIN(xb_ld(&bar[XB_TOPGEN]) == tg, bar);
            }
            __builtin_amdgcn_fence(__ATOMIC_ACQUIRE, "agent");
            xb_add(&bar[XB_XGEN(bx)], 1u);
            asm volatile("s_waitcnt vmcnt(0)" ::: "memory");
        } else {
            XB_SPIN(xb_ld(&bar[XB_XGEN(bx)]) == gen, bar);
            __builtin_amdgcn_fence(__ATOMIC_ACQUIRE, "agent");
            asm volatile("s_waitcnt vmcnt(0)" ::: "memory");
        }
    }
    __syncthreads();
}

constexpr int NWAVES = 8, NTHREADS = NWAVES * 64;
constexpr int LDS_BYTES = 163840;
constexpr int LDSCTL_OFF = LDS_BYTES - 512, MISC_OFF = LDSCTL_OFF + 320, QSLOT_OFF = LDSCTL_OFF + 448;
struct Ctx { int tid, lane, wave, wg, nwg, g, ng; LAS unsigned char* lds; };
__device__ __forceinline__ int opaque_tid(int wave) { int z = 0; asm volatile("" : "+v"(z)); return wave * 64 + (int)__builtin_amdgcn_mbcnt_hi(~0u, __builtin_amdgcn_mbcnt_lo(~0u, (unsigned)z)); }
struct Args { const void* in[30]; float* out; unsigned char* ws; int ph_lo, ph_hi; };
__device__ __forceinline__ const void* in_ptr(const Args& a, int i) { asm volatile("" : "+s"(i)); return a.in[i]; }

__device__ __forceinline__ int cmap_proj(int n) {
    if (n < PC_CQ) return n;
    if (n < PC_CKV) return 1544 + (n - PC_CQ);
    if (n < PC_KR) return 1800 + (n - PC_CKV);
    if (n < PC_G) return 1928 + (n - PC_KR);
    if (n < PC_G + 8) return 1536 + (n - PC_G);
    return -1;
}
__device__ __forceinline__ int cmap_ukv(int n) { const int part = n >> 9, h = (n >> 7) & 3, j = n & 127; return h * 256 + part * 128 + j; }
struct WDesc { const float* W; const float* g; bf16_t* Wt; int K, N, Npad, kind, row_off, ldw, kcol0; };
__device__ __forceinline__ void conv_item(LAS float* scr, int lane, const WDesc& d, int it) {
    const int nblk = d.Npad / 32, kb = it / nblk, nb = it % nblk, k0 = 64 * kb, n0 = 32 * nb;
    const int np = n0 + (lane & 31);
    const int src = d.kind == 1 ? cmap_proj(np) : d.kind == 2 ? cmap_ukv(np) : np;
    float wv[32];
#pragma unroll
    for (int i = 0; i < 32; ++i) { const int kk = 2 * i + (lane >> 5); wv[i] = src >= 0 ? d.W[(size_t)(k0 + kk) * d.N + src] : 0.f; }
    const float g0 = d.g ? d.g[k0 + (lane & 31) * 2] : 1.0f, g1 = d.g ? d.g[k0 + (lane & 31) * 2 + 1] : 1.0f;
#pragma unroll
    for (int i = 0; i < 32; ++i) { const int kk = 2 * i + (lane >> 5); const float gg = __int_as_float(__builtin_amdgcn_ds_bpermute((i + (lane & 32)) << 2, __float_as_int((lane >> 5) ? g1 : g0)));
        scr[kk * 33 + (lane & 31)] = wv[i] * gg; }
    asm volatile("s_waitcnt lgkmcnt(0)" ::: "memory");
    const int ch = lane & 7;
#pragma unroll
    for (int j = 0; j < 4; ++j) { const int n = (lane >> 3) + 8 * j; const LAS float* s = scr + (8 * ch) * 33 + n;
        u32x4 o; o.x = pk2(s[0 * 33], s[1 * 33]); o.y = pk2(s[2 * 33], s[3 * 33]); o.z = pk2(s[4 * 33], s[5 * 33]); o.w = pk2(s[6 * 33], s[7 * 33]);
        *(u32x4*)(d.Wt + (size_t)(d.row_off + n0 + n) * d.ldw + d.kcol0 + k0 + 8 * ch) = o; }
    asm volatile("s_waitcnt lgkmcnt(0)" ::: "memory");
}
__device__ __forceinline__ void rows_to_bf16_ssq(const Ctx& c, const float* src, bf16_t* dst, float* ssq, int nrows) {
    const int gw = c.wg * NWAVES + c.wave, NGW = c.nwg * NWAVES, lane = c.lane;
    for (int r0 = gw * 4; r0 < nrows; r0 += NGW * 4) {
        f32x4 v[4][4];
#pragma unroll
        for (int q = 0; q < 4; ++q)
#pragma unroll
            for (int j = 0; j < 4; ++j) v[q][j] = ((const f32x4*)(src + (size_t)(r0 + q) * D) + lane)[64 * j];
#pragma unroll
        for (int q = 0; q < 4; ++q) { unsigned long long* o8 = (unsigned long long*)(dst + (size_t)(r0 + q) * D) + lane; float s = 0.f;
#pragma unroll
            for (int j = 0; j < 4; ++j) { const f32x4 x = v[q][j]; s += (x.x * x.x + x.y * x.y) + (x.z * x.z + x.w * x.w); o8[64 * j] = (unsigned long long)pk2(x.x, x.y) | ((unsigned long long)pk2(x.z, x.w) << 32); }
            s = wave_sum(s, lane);
            if (lane < 16) ssq[(size_t)(r0 + q) * 16 + lane] = lane == 0 ? s : 0.f; }
    }
}
__device__ __forceinline__ void rope_tables(const Ctx& c, const int* pos, float* cosb, float* sinb) {
    const size_t gt = (size_t)c.wg * NTHREADS + c.tid, GT = (size_t)c.nwg * NTHREADS;
    for (size_t i = gt; i < (size_t)T * 32; i += GT) { const int t = (int)(i >> 5), k = (int)(i & 31);
        const float inv = exp2f(-(float)k * 0.41524101186092029f);
        const float ang = (float)pos[t] * inv; float sn, cs; sincosf(ang, &sn, &cs);
        cosb[i] = cs; sinb[i] = sn; }
}

namespace pg8 {
#define PG8_LAS __attribute__((address_space(3)))
typedef unsigned short bf16_t;
typedef short bf16x8 __attribute__((ext_vector_type(8)));
typedef float f32x4 __attribute__((ext_vector_type(4)));
typedef unsigned u32x4 __attribute__((ext_vector_type(4)));
constexpr int BM = 256, BK = 64, HALF = 128, HTB = HALF * BK * 2  , STAGE_BYTES = 8 * HTB, NXCD = 8, WGM = 8;

__host__ __device__ __forceinline__ int lds_byte(int r, int c) { const int st = (r >> 4) * 2 + (c >> 5), rr = r & 15, cc = c & 31, ob = rr * 64 + cc * 2; return st * 1024 + (ob ^ (((ob >> 9) & 1) << 5)); }
__host__ __device__ __forceinline__ void stage_rc(int b, int& R, int& C) { const int st = b / 1024, sb = b % 1024, swz = sb ^ (((sb >> 9) & 1) << 5); R = (st >> 1) * 16 + swz / 64; C = (st & 1) * 32 + (swz % 64) / 2; }
__host__ __device__ __forceinline__ int perm32(int rho) { const int n = rho >> 4, i = rho & 15; return 8 * (i >> 2) + 4 * n + (i & 3); }

struct Unit { int pm, pn; };
struct Gemm { const bf16_t* A; const bf16_t* Bt; int M, N, K, lda, ldb; size_t a_pn; };

struct StaticOrder {
    int nM, nN, nwg, G, c, wgm;
    __host__ __device__ void init(int M, int N, int G_, int c_, int wgm_ = WGM) { nM = M / BM; nN = N / BM; nwg = nM * nN; G = G_; c = c_; wgm = wgm_; }
    __host__ __device__ bool next(int i, Unit& u) const {
        const long L = (long)i * G + c; if (L >= nwg) return false;
        int wgid = (int)L; { const int q = nwg / NXCD, r = nwg % NXCD, xcd = wgid % NXCD, off = wgid / NXCD; wgid = (xcd < r ? xcd * (q + 1) : r * (q + 1) + (xcd - r) * q) + off; }
        const int nig = wgm * nN, gid = wgid / nig, fm = gid * wgm, gsz = (nM - fm) < wgm ? (nM - fm) : wgm;
        u.pm = fm + ((wgid % nig) % gsz); u.pn = (wgid % nig) / gsz; return true;
    }
    __device__ __forceinline__ void a_ready(const Unit&) const {}
    __device__ __forceinline__ void done(const Unit&) const {}
};

__device__ __forceinline__ unsigned cvt_pk_bf16(float lo, float hi) { unsigned r; asm volatile("v_cvt_pk_bf16_f32 %0, %1, %2\n\ts_nop 1" : "=v"(r) : "v"(lo), "v"(hi));     return r; }
__device__ __forceinline__ float rs_ssq16(const float* ssq, int row) {
    const f32x4* p = (const f32x4*)(ssq + (size_t)row * 16); const f32x4 a = (p[0] + p[1]) + (p[2] + p[3]);
    return __builtin_amdgcn_rsqf(((a.x + a.y) + (a.z + a.w)) * (1.0f / 1024.0f) + 1e-6f);
}
template <int MODE, int RS> struct EpiBf16S {
    static constexpr bool PERM = true, AFTER_DRAIN = false;
    bf16_t* O; int ldo; const float* rsrc; float* gates; const float* bi; const float* bfg; int rsmode;
    float* st_cq; float* st_ckv; float* st_kr; const float* hgain; int hgstride; PG8_LAS float* ex;
    __device__ __forceinline__ void rowscales(float (&rsv)[8], int row0, int fq, int lane) const {
        const bool m16 = RS == 1 || (RS == 3 && rsmode == 1), m4 = RS == 3 && rsmode >= 4;
        if (m16) { f32x4 p[8];
#pragma unroll
            for (int i = 0; i < 8; ++i) p[i] = *(const f32x4*)(rsrc + (size_t)(row0 + (i >> 2) * HALF + (i & 3) * 16) * 16 + 4 * fq);
#pragma unroll
            for (int i = 0; i < 8; ++i) { float s = (p[i].x + p[i].y) + (p[i].z + p[i].w); s += ::shx(s, 16, lane); s += ::shx(s, 32, lane); rsv[i] = __builtin_amdgcn_rsqf(s * (1.0f / 1024.0f) + 1e-6f); } }
        else if (m4) { float p[8]; const float inv = rsmode == 4 ? 1.0f / 256.0f : 1.0f / 128.0f;
#pragma unroll
            for (int i = 0; i < 8; ++i) p[i] = rsrc[(size_t)(row0 + (i >> 2) * HALF + (i & 3) * 16) * 4 + fq];
#pragma unroll
            for (int i = 0; i < 8; ++i) { float s = p[i]; s += ::shx(s, 16, lane); s += ::shx(s, 32, lane); rsv[i] = __builtin_amdgcn_rsqf(s * inv + 1e-6f); } }
        else {
#pragma unroll
            for (int i = 0; i < 8; ++i) rsv[i] = 1.0f; }
    }
    __device__ __forceinline__ void operator()(const f32x4 (&acc)[2][2][4][2], const Unit& u, int wr, int wc, int fr, int fq) const {
        const int row0 = u.pm * BM + wr * 64 + fr, col0 = u.pn * BM + wc * 32 + 8 * fq, lane = fq * 16 + fr;
        const bool gl = gates != nullptr && u.pn == 7 && wc == 2 && fq == 0;
        const bool st = RS == 3 && gates != nullptr && u.pn >= 6;
        const bool hn = RS == 3 && hgain != nullptr && ((u.pn >> 1) & 1) == 0;
        float rsv[8]; rowscales(rsv, row0, fq, lane);
        if (hn) {
#pragma unroll
            for (int ai = 0; ai < 2; ++ai)
#pragma unroll
                for (int m = 0; m < 4; ++m) { const int rl = ai * HALF + wr * 64 + m * 16 + fr; const float rs = rsv[ai * 4 + m];
#pragma unroll
                    for (int bj = 0; bj < 2; ++bj) { const f32x4 v0 = acc[ai][bj][m][0] * rs, v1 = acc[ai][bj][m][1] * rs;
                        float ss = ((v0[0] * v0[0] + v0[1] * v0[1]) + (v0[2] * v0[2] + v0[3] * v0[3])) + ((v1[0] * v1[0] + v1[1] * v1[1]) + (v1[2] * v1[2] + v1[3] * v1[3]));
                        ss += ::shx(ss, 16, lane); ss += ::shx(ss, 32, lane);
                        if (fq == 0) ex[(rl * 2 + bj) * 4 + wc] = ss; } }
            asm volatile("s_waitcnt lgkmcnt(0)" ::: "memory"); __builtin_amdgcn_s_barrier(); asm volatile("" ::: "memory");
        }
        f32x4 hg0 = {1.f, 1.f, 1.f, 1.f}, hg1 = {1.f, 1.f, 1.f, 1.f};
        if (hn) { const float* gp = hgain + (u.pn >> 2) * hgstride + wc * 32 + 8 * fq; hg0 = *(const f32x4*)gp; hg1 = *(const f32x4*)(gp + 4); }
#pragma unroll
        for (int ai = 0; ai < 2; ++ai)
#pragma unroll
            for (int m = 0; m < 4; ++m) { const int row = row0 + ai * HALF + m * 16, rl = ai * HALF + wr * 64 + m * 16 + fr; bf16_t* rowp = O + (size_t)row * ldo + col0;
                const float rs = rsv[ai * 4 + m];
                float sq = 0.f;
#pragma unroll
                for (int bj = 0; bj < 2; ++bj) { f32x4 v0 = acc[ai][bj][m][0] * rs, v1 = acc[ai][bj][m][1] * rs;
                    if (bj == 1 && gl) { *(f32x4*)(gates + (size_t)row * 8) = v0 + *(const f32x4*)bi; *(f32x4*)(gates + (size_t)row * 8 + 4) = v1 + *(const f32x4*)bfg; }
                    if (RS == 3 && gates != nullptr && (u.pn == 4 || u.pn == 5)) {
#pragma unroll
                        for (int e = 0; e < 4; ++e) { v0[e] = __builtin_amdgcn_rcpf(1.0f + __builtin_amdgcn_exp2f(-1.4426950408889634f * v0[e])); v1[e] = __builtin_amdgcn_rcpf(1.0f + __builtin_amdgcn_exp2f(-1.4426950408889634f * v1[e])); } }
                    if (st) { const float s8 = ((v0[0] * v0[0] + v0[1] * v0[1]) + (v0[2] * v0[2] + v0[3] * v0[3])) + ((v1[0] * v1[0] + v1[1] * v1[1]) + (v1[2] * v1[2] + v1[3] * v1[3]));
                        if (u.pn == 6) sq += s8;
                        else { float s = s8; s += ::shx(s, 16, lane); s += ::shx(s, 32, lane); if (fq == 0) { if (bj == 0) st_ckv[(size_t)row * 4 + wc] = s; else if (wc < 2) st_kr[(size_t)row * 2 + wc] = s; } } }
                    if (hn) { const f32x4 p = *(const PG8_LAS f32x4*)(ex + (rl * 2 + bj) * 4); const float rh = __builtin_amdgcn_rsqf(((p.x + p.y) + (p.z + p.w)) * (1.0f / 128.0f) + 1e-6f); v0 = v0 * rh * hg0; v1 = v1 * rh * hg1; }
                    if (MODE == 1) { v0 = __builtin_elementwise_max(v0, (f32x4){0.f, 0.f, 0.f, 0.f}); v1 = __builtin_elementwise_max(v1, (f32x4){0.f, 0.f, 0.f, 0.f}); v0 = v0 * v0; v1 = v1 * v1; }
                    u32x4 w; w.x = cvt_pk_bf16(v0[0], v0[1]); w.y = cvt_pk_bf16(v0[2], v0[3]); w.z = cvt_pk_bf16(v1[0], v1[1]); w.w = cvt_pk_bf16(v1[2], v1[3]);
                    *(u32x4*)(rowp + bj * HALF) = w; }
                if (st && u.pn == 6) { sq += ::shx(sq, 16, lane); sq += ::shx(sq, 32, lane); if (fq == 0) st_cq[(size_t)row * 4 + wc] = sq; } }
    }
};
struct EpiResidB {
    static constexpr bool PERM = true, AFTER_DRAIN = false;
    bf16_t* xb; float* xssq; float* outf;
    __device__ __forceinline__ void operator()(const f32x4 (&acc)[2][2][4][2], const Unit& u, int wr, int wc, int fr, int fq) const {
        const int row0 = u.pm * BM + wr * 64 + fr, col0 = u.pn * BM + wc * 32 + 8 * fq, lane = fq * 16 + fr;
#pragma unroll
        for (int ai = 0; ai < 2; ++ai) {
            u32x4 xin[4][2];
#pragma unroll
            for (int m = 0; m < 4; ++m)
#pragma unroll
                for (int bj = 0; bj < 2; ++bj) xin[m][bj] = *(const u32x4*)(xb + (size_t)(row0 + ai * HALF + m * 16) * 1024 + col0 + bj * HALF);
#pragma unroll
            for (int m = 0; m < 4; ++m) { const int row = row0 + ai * HALF + m * 16; const size_t off = (size_t)row * 1024 + col0; float ss = 0.f;
#pragma unroll
                for (int bj = 0; bj < 2; ++bj) { const u32x4 xw = xin[m][bj];
                    const f32x4 v0 = acc[ai][bj][m][0] + (f32x4){__uint_as_float(xw.x << 16), __uint_as_float(xw.x & 0xffff0000u), __uint_as_float(xw.y << 16), __uint_as_float(xw.y & 0xffff0000u)};
                    const f32x4 v1 = acc[ai][bj][m][1] + (f32x4){__uint_as_float(xw.z << 16), __uint_as_float(xw.z & 0xffff0000u), __uint_as_float(xw.w << 16), __uint_as_float(xw.w & 0xffff0000u)};
                    ss += ((v0[0] * v0[0] + v0[1] * v0[1]) + (v0[2] * v0[2] + v0[3] * v0[3])) + ((v1[0] * v1[0] + v1[1] * v1[1]) + (v1[2] * v1[2] + v1[3] * v1[3]));
                    u32x4 w; w.x = cvt_pk_bf16(v0[0], v0[1]); w.y = cvt_pk_bf16(v0[2], v0[3]); w.z = cvt_pk_bf16(v1[0], v1[1]); w.w = cvt_pk_bf16(v1[2], v1[3]);
                    *(u32x4*)(xb + off + bj * HALF) = w;
                    if (outf) { *(f32x4*)(outf + off + bj * HALF) = v0; *(f32x4*)(outf + off + bj * HALF + 4) = v1; } }
                ss += ::shx(ss, 16, lane); ss += ::shx(ss, 32, lane);
                if (fq == 0) xssq[(size_t)row * 16 + u.pn * 4 + wc] = ss; }
            asm volatile("" ::: "memory"); }
    }
};
template <class Epi, class Sched, bool ALIGN_EPI = false, bool SP2 = false>
__device__ __forceinline__ void gemm_phase(PG8_LAS unsigned char* lds, const Gemm g, const Sched& S, const Epi& E, int wave_id) {
    const int tid_ = opaque_tid(wave_id);
    int wid_ = wave_id; asm volatile("" : "+s"(wid_));
    const int tid = tid_, wid = wid_, lane = tid & 63, wr = wid >> 2, wc = wid & 3, fr = lane & 15, fq = lane >> 4;
    const int K = g.K, nt = K / BK;
    unsigned voffA[2], voffB[2];
#pragma unroll
    for (int i = 0; i < 2; ++i) { int R, C; stage_rc(tid * 16 + i * 8192, R, C); const int Rb = Epi::PERM ? ((R & ~31) + perm32(R & 31)) : R;
        voffA[i] = (unsigned)(R * g.lda + C) * 2u; voffB[i] = (unsigned)(Rb * g.ldb + C) * 2u; }
    const size_t kstep = (size_t)(BK * 2);
    const size_t hA = (size_t)HALF * g.lda * 2, hB = (size_t)HALF * g.ldb * 2;
    const size_t tA = 2 * hA, tB = 2 * hB;
    const unsigned ldsw = (unsigned)wid * 1024u;
    const int aoff = lds_byte(wr * 64 + fr, fq * 8), boff = lds_byte(wc * 32 + fr, fq * 8);
#define PG8_SA(b, h) (((b) * 2 + (h)) * HTB)
#define PG8_SB(b, h) ((4 + (b) * 2 + (h)) * HTB)
#define PG8_STAGE(bufoff, gbase, voff) do { _Pragma("unroll") for (int _i = 0; _i < 2; ++_i) \
        __builtin_amdgcn_global_load_lds((const unsigned*)((const char*)(gbase) + (voff)[_i]), (PG8_LAS unsigned*)(lds + (bufoff) + ldsw + _i * 8192), 16, 0, 0); } while (0)
#define PG8_LDA(dst, b, h) do { _Pragma("unroll") for (int m = 0; m < 4; ++m) _Pragma("unroll") for (int k = 0; k < 2; ++k) dst[m][k] = *(const PG8_LAS bf16x8*)(lds + PG8_SA(b, h) + aoff + m * 2048 + k * 1024); } while (0)
#define PG8_LDB(dst, b, h) do { _Pragma("unroll") for (int n = 0; n < 2; ++n) _Pragma("unroll") for (int k = 0; k < 2; ++k) dst[n][k] = *(const PG8_LAS bf16x8*)(lds + PG8_SB(b, h) + boff + n * 2048 + k * 1024); } while (0)
#define PG8_MMA(ai, bj, At, Bt) do { __builtin_amdgcn_s_setprio(1); _Pragma("unroll") for (int m = 0; m < 4; ++m) _Pragma("unroll") for (int n = 0; n < 2; ++n) _Pragma("unroll") for (int k = 0; k < 2; ++k) \
        acc[ai][bj][m][n] = __builtin_amdgcn_mfma_f32_16x16x32_bf16(Bt[n][k], At[m][k], acc[ai][bj][m][n], 0, 0, 0); __builtin_amdgcn_s_setprio(0); } while (0)
#define PG8_WAIT_V(n) asm volatile("s_waitcnt vmcnt(" #n ")" ::: "memory")
#define PG8_WAIT_L(n) asm volatile("s_waitcnt lgkmcnt(" #n ")" ::: "memory")
#define PG8_BAR __builtin_amdgcn_s_barrier()
#define PG8_SCHED __builtin_amdgcn_sched_barrier(0)
    Unit cur, nxt; int ui = 0;
    if (!S.next(0, cur)) return;
    f32x4 acc[2][2][4][2];
#pragma unroll
    for (int a = 0; a < 2; ++a)
#pragma unroll
        for (int b = 0; b < 2; ++b)
#pragma unroll
            for (int m = 0; m < 4; ++m)
#pragma unroll
                for (int n = 0; n < 2; ++n) acc[a][b][m][n] = (f32x4){0.f, 0.f, 0.f, 0.f};
    bf16x8 At[4][2], B0[2][2], B1[2][2];
    const char* cA = (const char*)g.A + (size_t)cur.pm * tA + (size_t)cur.pn * g.a_pn; const char* cB = (const char*)g.Bt + (size_t)cur.pn * tB;
    S.a_ready(cur);
    if constexpr (SP2) {
        PG8_STAGE(PG8_SB(0, 0), cB, voffB); PG8_STAGE(PG8_SB(0, 1), cB + hB, voffB); PG8_STAGE(PG8_SA(0, 0), cA, voffA); PG8_STAGE(PG8_SA(0, 1), cA + hA, voffA);
        if (wr == 1) PG8_BAR;
        PG8_WAIT_V(2); PG8_BAR;
        PG8_STAGE(PG8_SB(1, 0), cB + kstep, voffB); PG8_STAGE(PG8_SA(1, 0), cA + kstep, voffA); PG8_STAGE(PG8_SB(1, 1), cB + hB + kstep, voffB);
        PG8_WAIT_V(6); PG8_BAR;
    } else {
        PG8_STAGE(PG8_SB(0, 0), cB, voffB); PG8_STAGE(PG8_SA(0, 0), cA, voffA); PG8_STAGE(PG8_SB(0, 1), cB + hB, voffB); PG8_STAGE(PG8_SA(0, 1), cA + hA, voffA);
        if (wr == 1) PG8_BAR;
        PG8_WAIT_V(4); PG8_BAR;
        PG8_STAGE(PG8_SB(1, 0), cB + kstep, voffB); PG8_STAGE(PG8_SA(1, 0), cA + kstep, voffA); PG8_STAGE(PG8_SB(1, 1), cB + hB + kstep, voffB);
        PG8_WAIT_V(6); PG8_BAR;
    }
    for (;;) {
        const bool has_next = S.next(ui + 1, nxt);
        const char* nA = has_next ? (const char*)g.A + (size_t)nxt.pm * tA + (size_t)nxt.pn * g.a_pn : cA; const char* nB = has_next ? (const char*)g.Bt + (size_t)nxt.pn * tB : cB;
        for (int t = 0; t < nt; t += 2) {
            const bool last = (t == nt - 2);
            const char* a1 = cA + (size_t)(t + 1) * kstep;
            const char* a2 = last ? nA : cA + (size_t)(t + 2) * kstep; const char* b2 = last ? nB : cB + (size_t)(t + 2) * kstep;
            const char* a3 = a2 + kstep; const char* b3 = b2 + kstep;
            if (last && has_next) S.a_ready(nxt);
            if constexpr (SP2) {
            PG8_LDB(B0, 0, 0); PG8_LDB(B1, 0, 1); PG8_SCHED; PG8_LDA(At, 0, 0); PG8_STAGE(PG8_SA(1, 1), a1 + hA, voffA);
            PG8_WAIT_V(8); PG8_WAIT_L(0); PG8_BAR; PG8_MMA(0, 0, At, B0); PG8_MMA(0, 1, At, B1); PG8_BAR; PG8_SCHED;
            PG8_LDA(At, 0, 1); PG8_STAGE(PG8_SB(0, 0), b2, voffB); PG8_STAGE(PG8_SB(0, 1), b2 + hB, voffB); PG8_STAGE(PG8_SA(0, 0), a2, voffA);
            PG8_WAIT_V(8); PG8_WAIT_L(0); PG8_BAR; PG8_MMA(1, 0, At, B0); PG8_MMA(1, 1, At, B1); PG8_BAR; PG8_SCHED;
            PG8_LDB(B0, 1, 0); PG8_LDB(B1, 1, 1); PG8_SCHED; PG8_LDA(At, 1, 0); PG8_STAGE(PG8_SA(0, 1), a2 + hA, voffA);
            PG8_WAIT_V(8); PG8_WAIT_L(0); PG8_BAR; PG8_MMA(0, 0, At, B0); PG8_MMA(0, 1, At, B1); PG8_BAR; PG8_SCHED;
            PG8_LDA(At, 1, 1); PG8_STAGE(PG8_SB(1, 0), b3, voffB); PG8_STAGE(PG8_SB(1, 1), b3 + hB, voffB); PG8_STAGE(PG8_SA(1, 0), a3, voffA);
            PG8_WAIT_V(8); PG8_WAIT_L(0); PG8_BAR; PG8_MMA(1, 0, At, B0); PG8_MMA(1, 1, At, B1); PG8_BAR; PG8_SCHED;
            } else {
            PG8_LDB(B0, 0, 0); PG8_SCHED; PG8_LDA(At, 0, 0); PG8_STAGE(PG8_SA(1, 1), a1 + hA, voffA);
            PG8_WAIT_L(8); PG8_BAR; PG8_WAIT_L(0); PG8_MMA(0, 0, At, B0); PG8_BAR; PG8_SCHED;
            PG8_LDB(B1, 0, 1); PG8_STAGE(PG8_SB(0, 0), b2, voffB);
            PG8_BAR; PG8_WAIT_L(0); PG8_MMA(0, 1, At, B1); PG8_BAR;
            PG8_LDA(At, 0, 1); PG8_STAGE(PG8_SA(0, 0), a2, voffA);
            PG8_BAR; PG8_WAIT_L(0); PG8_MMA(1, 0, At, B0); PG8_BAR; PG8_SCHED;
            PG8_STAGE(PG8_SB(0, 1), b2 + hB, voffB);
            PG8_WAIT_V(6); PG8_BAR; PG8_MMA(1, 1, At, B1); PG8_BAR;
            PG8_LDB(B0, 1, 0); PG8_SCHED; PG8_LDA(At, 1, 0); PG8_STAGE(PG8_SA(0, 1), a2 + hA, voffA);
            PG8_WAIT_L(8); PG8_BAR; PG8_WAIT_L(0); PG8_MMA(0, 0, At, B0); PG8_BAR; PG8_SCHED;
            PG8_LDB(B1, 1, 1); PG8_STAGE(PG8_SB(1, 0), b3, voffB);
            PG8_BAR; PG8_WAIT_L(0); PG8_MMA(0, 1, At, B1); PG8_BAR;
            PG8_LDA(At, 1, 1); PG8_STAGE(PG8_SA(1, 0), a3, voffA);
            PG8_BAR; PG8_WAIT_L(0); PG8_MMA(1, 0, At, B0); PG8_BAR; PG8_SCHED;
            PG8_STAGE(PG8_SB(1, 1), b3 + hB, voffB);
            PG8_WAIT_V(6); PG8_BAR; PG8_MMA(1, 1, At, B1); PG8_BAR;
            }
        }
        if constexpr (ALIGN_EPI) { if (wr == 0) PG8_BAR; }
        if constexpr (!Epi::AFTER_DRAIN) { const int l2_ = opaque_tid(0) & 63; E(acc, cur, wr, wc, l2_ & 15, l2_ >> 4); S.done(cur); }
        if (!has_next) break;
#pragma unroll
        for (int a = 0; a < 2; ++a)
#pragma unroll
            for (int b = 0; b < 2; ++b)
#pragma unroll
                for (int m = 0; m < 4; ++m)
#pragma unroll
                    for (int n = 0; n < 2; ++n) acc[a][b][m][n] = (f32x4){0.f, 0.f, 0.f, 0.f};
        cur = nxt; cA = nA; cB = nB; ++ui;
        if constexpr (ALIGN_EPI) { if (wr == 1) PG8_BAR; }
    }
    PG8_WAIT_V(0);
    if constexpr (!ALIGN_EPI) { if (wr == 0) PG8_BAR; }
    PG8_BAR;
    if constexpr (Epi::AFTER_DRAIN) { E.fused(acc, cur, wr, wc, fr, fq, lds, wid, lane); S.done(cur); }
#undef PG8_SA
#undef PG8_SB
#undef PG8_STAGE
#undef PG8_LDA
#undef PG8_LDB
#undef PG8_MMA
#undef PG8_WAIT_V
#undef PG8_WAIT_L
#undef PG8_BAR
#undef PG8_SCHED
}
}

__device__ __forceinline__ void conv_slab(const Ctx& c, int pm, int pn, const bf16_t* proj, const float* cw, const float* cb, bf16_t* uc) {
    for (int it = c.tid; it < 64 * 32; it += NTHREADS) { const int t0 = 256 * pm + 4 * (it >> 5), ch0 = 256 * pn + 8 * (it & 31), s0 = t0 & (SEQ - 1);
        float wv[4][8], bv[8];
#pragma unroll
        for (int jt = 0; jt < 4; ++jt) { const f32x4 a = *(const f32x4*)(cw + jt * 512 + ch0), b = *(const f32x4*)(cw + jt * 512 + ch0 + 4);
#pragma unroll
            for (int e = 0; e < 4; ++e) { wv[jt][e] = a[e]; wv[jt][4 + e] = b[e]; } }
        { const f32x4 a = *(const f32x4*)(cb + ch0), b = *(const f32x4*)(cb + ch0 + 4);
#pragma unroll
          for (int e = 0; e < 4; ++e) { bv[e] = a[e]; bv[4 + e] = b[e]; } }
        float xr[7][8];
#pragma unroll
        for (int r = 0; r < 7; ++r) { u32x4 v = {0u, 0u, 0u, 0u}; if (s0 + r - 3 >= 0) v = *(const u32x4*)(proj + (size_t)(t0 + r - 3) * NPROJ + PC_U + ch0);
#pragma unroll
            for (int e = 0; e < 4; ++e) { xr[r][2 * e] = bflo(v[e]); xr[r][2 * e + 1] = bfhi(v[e]); } }
#pragma unroll
        for (int q = 0; q < 4; ++q) { u32x4 o;
#pragma unroll
            for (int e = 0; e < 4; ++e) { float a0 = bv[2 * e], a1 = bv[2 * e + 1];
#pragma unroll
                for (int jt = 0; jt < 4; ++jt) { a0 += wv[jt][2 * e] * xr[q + jt][2 * e]; a1 += wv[jt][2 * e + 1] * xr[q + jt][2 * e + 1]; }
                o[e] = pk2(a0 * sigmoidf_(a0), a1 * sigmoidf_(a1)); }
            *(u32x4*)(uc + (size_t)(t0 + q) * 512 + ch0) = o; }
    }
}
__device__ __forceinline__ void kr_prep(const Ctx& c, const bf16_t* proj, const float* gk, const float* cosb, const float* sinb, const float* st_kr, bf16_t* kr) {
    const size_t gt = (size_t)(c.wg / c.ng) * NTHREADS + c.tid, GT = (size_t)(c.nwg / c.ng) * NTHREADS, tg8 = (size_t)(T / c.ng) * 8;
    for (size_t i = gt; i < tg8; i += GT) { const size_t t = (size_t)c.g * (T / c.ng) + (i >> 3); const int i0 = (int)(i & 7) * 4; const bf16_t* pr = proj + t * NPROJ + PC_KR;
        const u32x2 a = *(const u32x2*)(pr + i0), b = *(const u32x2*)(pr + 32 + i0);
        const float rs = rsqrtf((st_kr[t * 2] + st_kr[t * 2 + 1]) * (1.0f / 64.0f) + EPS);
        const f32x4 ga = *(const f32x4*)(gk + 128 + i0), gb = *(const f32x4*)(gk + 160 + i0), cs = *(const f32x4*)(cosb + t * 32 + i0), sn = *(const f32x4*)(sinb + t * 32 + i0);
        const float y1[4] = {bflo(a.x) * rs * ga[0], bfhi(a.x) * rs * ga[1], bflo(a.y) * rs * ga[2], bfhi(a.y) * rs * ga[3]}, y2[4] = {bflo(b.x) * rs * gb[0], bfhi(b.x) * rs * gb[1], bflo(b.y) * rs * gb[2], bfhi(b.y) * rs * gb[3]};
        u32x2 oa, ob; oa.x = pk2(y1[0] * cs[0] - y2[0] * sn[0], y1[1] * cs[1] - y2[1] * sn[1]); oa.y = pk2(y1[2] * cs[2] - y2[2] * sn[2], y1[3] * cs[3] - y2[3] * sn[3]);
        ob.x = pk2(y2[0] * cs[0] + y1[0] * sn[0], y2[1] * cs[1] + y1[1] * sn[1]); ob.y = pk2(y2[2] * cs[2] + y1[2] * sn[2], y2[3] * cs[3] + y1[3] * sn[3]);
        *(u32x2*)(kr + t * 64 + i0) = oa; *(u32x2*)(kr + t * 64 + 32 + i0) = ob; }
}
typedef short bf16x8_t __attribute__((ext_vector_type(8)));
typedef short s16x4_t __attribute__((ext_vector_type(4)));
typedef float f32x16 __attribute__((ext_vector_type(16)));
__device__ __forceinline__ unsigned cvtpk_bf16(float lo, float hi) { unsigned r; asm volatile("v_cvt_pk_bf16_f32 %0, %1, %2\n\ts_nop 1" : "=v"(r) : "v"(lo), "v"(hi));     return r; }
#define TR_READ(dst, base, OFF) asm volatile("ds_read_b64_tr_b16 %0, %1 offset:%2" : "=&v"(dst) : "v"(base), "i"(OFF) : "memory")
#define TR_WAIT() do { asm volatile("s_waitcnt lgkmcnt(0)" ::: "memory"); __builtin_amdgcn_sched_barrier(0); } while (0)
#define TR_PACK(lo_, hh_) ((bf16x8_t){lo_[0], lo_[1], lo_[2], lo_[3], hh_[0], hh_[1], hh_[2], hh_[3]})
__device__ __forceinline__ float xhalf_max(float v) { auto rr = __builtin_amdgcn_permlane32_swap(__float_as_uint(v), __float_as_uint(v), false, false); return fmaxf(__uint_as_float(rr[0]), __uint_as_float(rr[1])); }
__device__ __forceinline__ float xhalf_sum(float v) { auto rr = __builtin_amdgcn_permlane32_swap(__float_as_uint(v), __float_as_uint(v), false, false); return __uint_as_float(rr[0]) + __uint_as_float(rr[1]); }
template <int DQ, bool CAUSAL, bool ONORM>
__device__ __forceinline__ void attn_block(const Ctx& c, int b, int h, int qb, const bf16_t* Q, int ldq, const bf16_t* K1, int ldk1, const bf16_t* K2, const bf16_t* V, int ldv, int SK, bf16_t* O, int ldo, int ocol0, const float* gain,
                                           const float* gq, const float* cosb, const float* sinb, float qscale) {
    constexpr int NI1 = 17, NI2 = DQ == 192 ? 9 : 0, NIV = 20, NINS = NI1 + NI2 + NIV, BUFB = NINS * 1024, K1P = 272, K2P = 144, VP = 320, NKS = DQ / 16, NPW = (NINS + 7) / 8;
    static_assert(2 * BUFB <= LDSCTL_OFF && (DQ == 192 || DQ == 128), "attn_mfma geometry");
    const int lane = c.lane, w = c.wave, q32 = lane & 31, hi = lane >> 5;
    LAS unsigned char* const lds = c.lds;
    const int vrd = (4 * (lane >> 5) + ((lane >> 2) & 3)) * VP + (16 * ((lane >> 4) & 1) + 4 * (lane & 3)) * 2;
    unsigned soff[NPW];
#pragma unroll
    for (int i = 0; i < NPW; ++i) { const int idx = w + 8 * i, ci = idx * 64 + lane;
        if (idx < NI1) { const int key = ci / 17, ch = ci % 17; soff[i] = (unsigned)(key * ldk1 * 2 + (ch < 15 ? ch : 15) * 16); }
        else if (idx < NI1 + NI2) { const int cc = ci - NI1 * 64, key = cc / 9, ch = cc % 9; soff[i] = (unsigned)(key * 128 + (ch < 7 ? ch : 7) * 16); }
        else { const int cc = ci - (NI1 + NI2) * 64, key = cc / 20, ch = cc % 20; soff[i] = (unsigned)(key * ldv * 2 + (ch < 15 ? ch : 15) * 16); } }
    {
        {
            const int NT = CAUSAL ? 4 * qb + 4 : SK / 64;
            const size_t kbase = (size_t)b * SK, qrow = (size_t)b * SEQ + qb * 256 + w * 32 + q32;
            const int qg = qb * 256 + w * 32 + q32;
            bf16x8_t qf[NKS];
#pragma unroll
            for (int ks = 0; ks < NKS; ++ks) qf[ks] = *(const bf16x8_t*)(Q + qrow * ldq + h * DQ + 16 * ks + 8 * hi);
            {
                float ss = 0.f;
#pragma unroll
                for (int ks = 0; ks < 8; ++ks) { const u32x4 wq = __builtin_bit_cast(u32x4, qf[ks]);
#pragma unroll
                    for (int i = 0; i < 4; ++i) ss += bflo(wq[i]) * bflo(wq[i]) + bfhi(wq[i]) * bfhi(wq[i]); }
                const float rs = rsqrtf(xhalf_sum(ss) * (1.0f / 128.0f) + EPS) * qscale;
#pragma unroll
                for (int ks = 0; ks < 8; ++ks) { const u32x4 wq = __builtin_bit_cast(u32x4, qf[ks]); const f32x4 g0 = *(const f32x4*)(gq + 16 * ks + 8 * hi), g1 = *(const f32x4*)(gq + 16 * ks + 8 * hi + 4); u32x4 o4;
                    o4[0] = cvtpk_bf16(bflo(wq[0]) * rs * g0[0], bfhi(wq[0]) * rs * g0[1]); o4[1] = cvtpk_bf16(bflo(wq[1]) * rs * g0[2], bfhi(wq[1]) * rs * g0[3]);
                    o4[2] = cvtpk_bf16(bflo(wq[2]) * rs * g1[0], bfhi(wq[2]) * rs * g1[1]); o4[3] = cvtpk_bf16(bflo(wq[3]) * rs * g1[2], bfhi(wq[3]) * rs * g1[3]);
                    qf[ks] = __builtin_bit_cast(bf16x8_t, o4); }
                if (DQ == 192) {
                    float sr = 0.f;
#pragma unroll
                    for (int ks = 8; ks < NKS; ++ks) { const u32x4 wq = __builtin_bit_cast(u32x4, qf[ks]);
#pragma unroll
                        for (int i = 0; i < 4; ++i) sr += bflo(wq[i]) * bflo(wq[i]) + bfhi(wq[i]) * bfhi(wq[i]); }
                    const float rr = rsqrtf(xhalf_sum(sr) * (1.0f / 64.0f) + EPS);
#pragma unroll
                    for (int kp = 0; kp < 2; ++kp) {
                        const int i0 = 16 * kp + 8 * hi; const u32x4 wa = __builtin_bit_cast(u32x4, qf[8 + kp]), wb = __builtin_bit_cast(u32x4, qf[10 + kp]);
                        float y1[8], y2[8], cs[8], sn[8], ga[8], gb[8];
#pragma unroll
                        for (int q4 = 0; q4 < 2; ++q4) { const f32x4 c4 = *(const f32x4*)(cosb + qrow * 32 + i0 + 4 * q4), s4 = *(const f32x4*)(sinb + qrow * 32 + i0 + 4 * q4), a4 = *(const f32x4*)(gq + 128 + i0 + 4 * q4), b4 = *(const f32x4*)(gq + 160 + i0 + 4 * q4);
#pragma unroll
                            for (int e = 0; e < 4; ++e) { cs[4 * q4 + e] = c4[e]; sn[4 * q4 + e] = s4[e]; ga[4 * q4 + e] = a4[e]; gb[4 * q4 + e] = b4[e]; } }
#pragma unroll
                        for (int i = 0; i < 4; ++i) { y1[2 * i] = bflo(wa[i]) * rr * ga[2 * i]; y1[2 * i + 1] = bfhi(wa[i]) * rr * ga[2 * i + 1]; y2[2 * i] = bflo(wb[i]) * rr * gb[2 * i]; y2[2 * i + 1] = bfhi(wb[i]) * rr * gb[2 * i + 1]; }
                        u32x4 oa, ob;
#pragma unroll
                        for (int i = 0; i < 4; ++i) { oa[i] = cvtpk_bf16((y1[2 * i] * cs[2 * i] - y2[2 * i] * sn[2 * i]) * qscale, (y1[2 * i + 1] * cs[2 * i + 1] - y2[2 * i + 1] * sn[2 * i + 1]) * qscale);
                                                      ob[i] = cvtpk_bf16((y2[2 * i] * cs[2 * i] + y1[2 * i] * sn[2 * i]) * qscale, (y2[2 * i + 1] * cs[2 * i + 1] + y1[2 * i + 1] * sn[2 * i + 1]) * qscale); }
                        qf[8 + kp] = __builtin_bit_cast(bf16x8_t, oa); qf[10 + kp] = __builtin_bit_cast(bf16x8_t, ob); }
                }
            }
            f32x16 o[4];
#pragma unroll
            for (int d = 0; d < 4; ++d)
#pragma unroll
                for (int r = 0; r < 16; ++r) o[d][r] = 0.f;
            float m = -1e30f, l = 0.f;
            const unsigned char* g1 = (const unsigned char*)(K1 + kbase * ldk1 + h * 128);
            const unsigned char* g2 = (const unsigned char*)(K2 + kbase * 64);
            const unsigned char* gv = (const unsigned char*)(V + kbase * ldv + h * 128);
#define ATT_DMA(t_, buf_) do { \
                _Pragma("unroll") for (int i = 0; i < NPW; ++i) { const int idx = w + 8 * i; if (idx < NINS) { \
                    const unsigned char* gp = idx < NI1 ? g1 + (size_t)(t_) * 128 * ldk1 : idx < NI1 + NI2 ? g2 + (size_t)(t_) * 8192 : gv + (size_t)(t_) * 128 * ldv; \
                    __builtin_amdgcn_global_load_lds((const unsigned*)(gp + soff[i]), (LAS unsigned*)(lds + (buf_) * BUFB + idx * 1024), 16, 0, 0); } } } while (0)
            ATT_DMA(0, 0);
            asm volatile("s_waitcnt vmcnt(0)" ::: "memory");
            __syncthreads();
            for (int t = 0; t < NT; ++t) {
                const int buf = t & 1;
                if (t + 1 < NT) ATT_DMA(t + 1, buf ^ 1);
                if (!CAUSAL || 64 * t <= qb * 256 + w * 32 + 31) {
                    const LAS unsigned char* Kb = lds + buf * BUFB + q32 * K1P + hi * 16;
                    const LAS unsigned char* Kb2 = lds + buf * BUFB + NI1 * 1024 + q32 * K2P + hi * 16;
                    f32x16 p0, p1;
#pragma unroll
                    for (int r = 0; r < 16; ++r) { p0[r] = 0.f; p1[r] = 0.f; }
                    {
                        const unsigned kba = (unsigned)(size_t)Kb, kba2 = (unsigned)(size_t)Kb2;
                        bf16x8_t ka0, ka1, kb0, kb1;
#define ATT_KR(dst, base, OFF) asm volatile("ds_read_b128 %0, %1 offset:%2" : "=&v"(dst) : "v"(base), "i"(OFF) : "memory")
#define ATT_KRD(ks_, D0, D1) do { if ((ks_) < 8) { ATT_KR(D0, kba, ((ks_) & 7) * 32); ATT_KR(D1, kba, 32 * K1P + ((ks_) & 7) * 32); } else { ATT_KR(D0, kba2, ((ks_) & 7) * 32); ATT_KR(D1, kba2, 32 * K2P + ((ks_) & 7) * 32); } } while (0)
#define ATT_KSTEP(ks_, C0, C1, N0, N1) do { if ((ks_) + 1 < NKS) { ATT_KRD((ks_) + 1, N0, N1); asm volatile("s_waitcnt lgkmcnt(2)" ::: "memory"); } else asm volatile("s_waitcnt lgkmcnt(0)" ::: "memory"); \
                            __builtin_amdgcn_sched_barrier(0); \
                            p0 = __builtin_amdgcn_mfma_f32_32x32x16_bf16(C0, qf[ks_], p0, 0, 0, 0); p1 = __builtin_amdgcn_mfma_f32_32x32x16_bf16(C1, qf[ks_], p1, 0, 0, 0); \
                            __builtin_amdgcn_sched_barrier(0); } while (0)
                        ATT_KRD(0, ka0, ka1);
                        ATT_KSTEP(0, ka0, ka1, kb0, kb1); ATT_KSTEP(1, kb0, kb1, ka0, ka1); ATT_KSTEP(2, ka0, ka1, kb0, kb1); ATT_KSTEP(3, kb0, kb1, ka0, ka1);
                        ATT_KSTEP(4, ka0, ka1, kb0, kb1); ATT_KSTEP(5, kb0, kb1, ka0, ka1); ATT_KSTEP(6, ka0, ka1, kb0, kb1); ATT_KSTEP(7, kb0, kb1, ka0, ka1);
                        if (NKS > 8) { ATT_KSTEP(8, ka0, ka1, kb0, kb1); ATT_KSTEP(9, kb0, kb1, ka0, ka1); ATT_KSTEP(10, ka0, ka1, kb0, kb1); ATT_KSTEP(11, kb0, kb1, ka0, ka1); }
#undef ATT_KR
#undef ATT_KRD
#undef ATT_KSTEP
                    }
                    if (CAUSAL && t >= 4 * qb) {
                        const int d0 = qg - 64 * t - 4 * hi;
#pragma unroll
                        for (int r = 0; r < 16; ++r) { const int cr = (r & 3) + 8 * (r >> 2); if (cr > d0) p0[r] = -INFINITY; if (cr + 32 > d0) p1[r] = -INFINITY; }
                    }
                    const unsigned vba = (unsigned)(size_t)(lds + buf * BUFB + (NI1 + NI2) * 1024 + vrd);
#define ATT_PVR(S, L0, H0, L1, H1, L2, H2, L3, H3) do { \
                        TR_READ(L0, vba, (16 * (S)) * VP + 0); TR_READ(H0, vba, (16 * (S) + 8) * VP + 0); TR_READ(L1, vba, (16 * (S)) * VP + 64); TR_READ(H1, vba, (16 * (S) + 8) * VP + 64); \
                        TR_READ(L2, vba, (16 * (S)) * VP + 128); TR_READ(H2, vba, (16 * (S) + 8) * VP + 128); TR_READ(L3, vba, (16 * (S)) * VP + 192); TR_READ(H3, vba, (16 * (S) + 8) * VP + 192); } while (0)
#define ATT_PVC(S, PF) do { u32x4 pw_; \
                        _Pragma("unroll") for (int j_ = 0; j_ < 4; ++j_) pw_[j_] = (S) < 2 ? cvtpk_bf16(p0[8 * (S) + 2 * j_], p0[8 * (S) + 2 * j_ + 1]) : cvtpk_bf16(p1[8 * ((S) - 2) + 2 * j_], p1[8 * ((S) - 2) + 2 * j_ + 1]); \
                        PF = __builtin_bit_cast(bf16x8_t, pw_); } while (0)
#define ATT_PVM(PF, L0, H0, L1, H1, L2, H2, L3, H3) do { \
                        o[0] = __builtin_amdgcn_mfma_f32_32x32x16_bf16(TR_PACK(L0, H0), PF, o[0], 0, 0, 0); o[1] = __builtin_amdgcn_mfma_f32_32x32x16_bf16(TR_PACK(L1, H1), PF, o[1], 0, 0, 0); \
                        o[2] = __builtin_amdgcn_mfma_f32_32x32x16_bf16(TR_PACK(L2, H2), PF, o[2], 0, 0, 0); o[3] = __builtin_amdgcn_mfma_f32_32x32x16_bf16(TR_PACK(L3, H3), PF, o[3], 0, 0, 0); } while (0)
#define TR_WAITN(n) do { asm volatile("s_waitcnt lgkmcnt(" #n ")" ::: "memory"); __builtin_amdgcn_sched_barrier(0); } while (0)
                    bf16x8_t pfa, pfb; s16x4_t la0, ha0, la1, ha1, la2, ha2, la3, ha3, lb0, hb0, lb1, hb1, lb2, hb2, lb3, hb3;
                    ATT_PVR(0, la0, ha0, la1, ha1, la2, ha2, la3, ha3);
                    ATT_PVR(1, lb0, hb0, lb1, hb1, lb2, hb2, lb3, hb3);
                    float mx = fmaxf(p0[0], p1[0]);
#pragma unroll
                    for (int r = 1; r < 16; ++r) mx = fmaxf(mx, fmaxf(p0[r], p1[r]));
                    mx = xhalf_max(mx);
                    float mn = m, alpha = 1.0f;
                    if (!__all(mx - m <= 8.0f)) { mn = fmaxf(m, mx); alpha = __builtin_amdgcn_exp2f(m - mn); m = mn; }
                    float ps = 0.f;
#pragma unroll
                    for (int r = 0; r < 16; ++r) { p0[r] = __builtin_amdgcn_exp2f(p0[r] - mn); p1[r] = __builtin_amdgcn_exp2f(p1[r] - mn); ps += p0[r] + p1[r]; }
                    l = l * alpha + ps;
                    if (!__all(alpha == 1.0f)) {
#pragma unroll
                        for (int d = 0; d < 4; ++d)
#pragma unroll
                            for (int r = 0; r < 16; ++r) o[d][r] *= alpha;
                    }
                    ATT_PVC(0, pfa); ATT_PVC(1, pfb);
                    TR_WAITN(8); ATT_PVM(pfa, la0, ha0, la1, ha1, la2, ha2, la3, ha3);
                    ATT_PVR(2, la0, ha0, la1, ha1, la2, ha2, la3, ha3); ATT_PVC(2, pfa);
                    TR_WAITN(8); ATT_PVM(pfb, lb0, hb0, lb1, hb1, lb2, hb2, lb3, hb3);
                    ATT_PVR(3, lb0, hb0, lb1, hb1, lb2, hb2, lb3, hb3); ATT_PVC(3, pfb);
                    TR_WAITN(8); ATT_PVM(pfa, la0, ha0, la1, ha1, la2, ha2, la3, ha3);
                    TR_WAITN(0); ATT_PVM(pfb, lb0, hb0, lb1, hb1, lb2, hb2, lb3, hb3);
#undef ATT_PVR
#undef ATT_PVC
#undef ATT_PVM
#undef TR_WAITN
                }
                asm volatile("s_waitcnt vmcnt(0)" ::: "memory");
                __syncthreads();
            }
#undef ATT_DMA
            const float inv = __builtin_amdgcn_rcpf(xhalf_sum(l));
            float ss = 0.f;
#pragma unroll
            for (int d = 0; d < 4; ++d)
#pragma unroll
                for (int r = 0; r < 16; ++r) { o[d][r] *= inv; ss += o[d][r] * o[d][r]; }
            float rs = 1.0f;
            if (ONORM) rs = rsqrtf(xhalf_sum(ss) * (1.0f / 128.0f) + EPS);
            LAS unsigned char* stg = lds + w * (32 * 272);
#pragma unroll
            for (int d = 0; d < 4; ++d)
#pragma unroll
                for (int r4 = 0; r4 < 4; ++r4) { const int dv = 32 * d + 8 * r4;
                    f32x4 v = {o[d][4 * r4], o[d][4 * r4 + 1], o[d][4 * r4 + 2], o[d][4 * r4 + 3]};
                    if (ONORM) v = v * rs * *(const f32x4*)(gain + h * 128 + dv + 4 * hi);
                    u32x2 wv; wv.x = cvtpk_bf16(v[0], v[1]); wv.y = cvtpk_bf16(v[2], v[3]); *(LAS u32x2*)(stg + q32 * 272 + (dv + 4 * hi) * 2) = wv; }
            asm volatile("s_waitcnt lgkmcnt(0)" ::: "memory");
            bf16_t* ob = O + ((size_t)b * SEQ + qb * 256 + w * 32) * ldo + ocol0 + h * 128;
#pragma unroll
            for (int i2 = 0; i2 < 8; ++i2) { const int pcs = lane + 64 * i2, row = pcs >> 4, pc = pcs & 15; *(u32x4*)(ob + (size_t)row * ldo + pc * 8) = *(const LAS u32x4*)(stg + row * 272 + pc * 16); }
            __syncthreads();
        }
    }
}


template <int DQ, bool CAUSAL, bool ONORM>
__device__ __forceinline__ void attn_mfma(const Ctx& c, const bf16_t* Q, int ldq, const bf16_t* K1, int ldk1, const bf16_t* K2, const bf16_t* V, int ldv, int SK, bf16_t* O, int ldo, int ocol0, const float* gain, const float* gq, const float* cosb, const float* sinb, float qscale) {
    const int vcu = (c.nwg % 8 == 0) ? (c.wg % 8) * (c.nwg / 8) + c.wg / 8 : c.wg;
    for (int item = vcu; item < BATCH * 4 * 8; item += c.nwg) attn_block<DQ, CAUSAL, ONORM>(c, item >> 5, (item >> 3) & 3, item & 7, Q, ldq, K1, ldk1, K2, V, ldv, SK, O, ldo, ocol0, gain, gq, cosb, sinb, qscale);
}
__device__ __forceinline__ float lane_get(float v, int src) { return __int_as_float(__builtin_amdgcn_ds_bpermute(src << 2, __float_as_int(v))); }
__device__ __forceinline__ bf16x8_t scale8(bf16x8_t f, float s) { const u32x4 w = __builtin_bit_cast(u32x4, f); u32x4 o;
#pragma unroll
    for (int i = 0; i < 4; ++i) o[i] = cvtpk_bf16(bflo(w[i]) * s, bfhi(w[i]) * s);
    return __builtin_bit_cast(bf16x8_t, o); }
__device__ __forceinline__ void mlstm_unit(const Ctx& c, int unit, bf16_t* qkm, const bf16_t* proj, const float* gates, const float* mg, bf16_t* ymix) {
    constexpr int QP = 144, VP = 320, NINS = 38, BUFB = NINS * 1024, KOFF = 9 * 1024, VOFF = 18 * 1024, COFF = 2 * BUFB, NOFF = COFF + 64 * VP, SSOFF = NOFF + 256, NPOFF = SSOFF + 1024, EGOFF = NPOFF + 2048,
                  SJOFF = EGOFF + 8192, EOFF = SJOFF + 8192, BTOFF = EOFF + 8192, P63OFF = BTOFF + 128, SOOFF = P63OFF + 128, CCOFF = SOOFF + 128, OTOFF = CCOFF + 128, OP = 272, YTOFF = OTOFF + 64 * OP, EUOFF = YTOFF  ,
                  LEND = YTOFF + 64 * OP, NPW = 5, NCHUNK = SEQ / 64;
    static_assert(LEND <= LDSCTL_OFF, "mlstm LDS map");
    const int lane = c.lane, w = c.wave, c32 = lane & 31, hi = lane >> 5, x = w >> 2, dvb = w & 3, tid = c.tid;
    LAS unsigned char* const lds = c.lds;
    unsigned soff[NPW];
#pragma unroll
    for (int i = 0; i < NPW; ++i) { const int idx = w + 8 * i, ci = idx * 64 + lane;
        if (idx < 9) { const int key = ci / 9, ch = ci % 9; soff[i] = (unsigned)(key * 1024 + (ch < 7 ? ch : 7) * 16); }
        else if (idx < 18) { const int cc = ci - 576, key = cc / 9, ch = cc % 9; soff[i] = (unsigned)(key * 1024 + 128 + (ch < 7 ? ch : 7) * 16); }
        else { const int cc = ci - 1152, key = cc / 20, ch = cc % 20; soff[i] = (unsigned)(key * 4096 + (ch < 15 ? ch : 15) * 16); } }
    unsigned ooff[3];
#pragma unroll
    for (int i = 0; i < 3; ++i) { const int ci = (w + 8 * i) * 64 + lane, key = ci / 17, chn = ci % 17; ooff[i] = (unsigned)(key * 4096 + (chn < 15 ? chn : 15) * 16); }
    const int colb = (16 * ((lane >> 4) & 1) + 4 * (lane & 3)) * 2, rq = (lane >> 2) & 3;
    const int vrd = (4 * hi + rq) * VP + colb + 64 * dvb;
    const int crd = (8 * hi + rq) * VP + colb + 64 * dvb;
    const int krd = (4 * hi + rq) * QP + colb + 64 * x;
    const int j = 32 * x + c32;
    const int b = unit >> 2, h = unit & 3; const size_t t0 = (size_t)b * SEQ;
    const unsigned char* gq = (const unsigned char*)(qkm + t0 * 512 + h * 128);
    const unsigned char* gv = (const unsigned char*)(proj + t0 * NPROJ + PC_V + h * 128);
#define ML_DMA(ch_, buf_) do { \
        _Pragma("unroll") for (int i = 0; i < NPW; ++i) { const int idx = w + 8 * i; if (idx < NINS) { \
            const unsigned char* gp = idx < 18 ? gq + (size_t)(ch_) * 65536 : gv + (size_t)(ch_) * 262144; \
            __builtin_amdgcn_global_load_lds((const unsigned*)(gp + soff[i]), (LAS unsigned*)(lds + (buf_) * BUFB + idx * 1024), 16, 0, 16  ); } } } while (0)
    const unsigned char* go = (const unsigned char*)(proj + t0 * NPROJ + PC_O + h * 128);
#define ML_DMA_O(ch_) do { _Pragma("unroll") for (int i = 0; i < 3; ++i) { const int idx = w + 8 * i; if (idx < 17) \
            __builtin_amdgcn_global_load_lds((const unsigned*)(go + (size_t)(ch_) * 262144 + ooff[i]), (LAS unsigned*)(lds + OTOFF + idx * 1024), 16, 0, 0); } } while (0)
#define ML_YSTORE(ch_) do { _Pragma("unroll") for (int i = 0; i < 2; ++i) { const int p_ = tid + NTHREADS * i, row_ = p_ >> 4, pc_ = p_ & 15; \
            *(u32x4*)(ymix + (t0 + (size_t)(ch_) * 64 + row_) * D + h * 128 + pc_ * 8) = *(const LAS u32x4*)(lds + YTOFF + row_ * OP + pc_ * 16); } } while (0)
    for (int i = tid; i < (64 * VP + 256) / 4; i += NTHREADS) ((LAS unsigned*)(lds + COFF))[i] = 0u;
    float bsq[4], pmq[4], uq[4];
    {   float igq[4], fgq[4];
#pragma unroll
        for (int q = 0; q < 4; ++q) { const size_t t = t0 + (size_t)(4 * w + q) * 64 + lane; igq[q] = gates[t * 8 + h]; fgq[q] = gates[t * 8 + 4 + h]; }
#pragma unroll
        for (int q = 0; q < 4; ++q) { const float fg = fgq[q]; float bs = fminf(fg, 0.f) - log1pf(__expf(-fabsf(fg)));
#pragma unroll
            for (int o = 1; o < 64; o <<= 1) { const float t = lane_get(bs, lane - o); if (lane >= o) bs += t; }
            const float u = igq[q] - bs; float pm = u;
#pragma unroll
            for (int o = 1; o < 64; o <<= 1) { const float t = lane_get(pm, lane - o); if (lane >= o) pm = fmaxf(pm, t); }
            bsq[q] = bs; pmq[q] = pm; uq[q] = u;
            if (lane == 63) { *(LAS float*)(lds + BTOFF + (4 * w + q) * 4) = bs; *(LAS float*)(lds + P63OFF + (4 * w + q) * 4) = pm; } }
    }
    __syncthreads();
    float mpq[4];
    {   float m = 0.f;
        for (int cc = 0; cc < NCHUNK; ++cc) { const float bt = *(const LAS float*)(lds + BTOFF + cc * 4), p63 = *(const LAS float*)(lds + P63OFF + cc * 4), mn = fmaxf(bt + m, bt + p63);
            if (w == 0 && lane == 0) { *(LAS float*)(lds + SOOFF + cc * 4) = __expf(bt + m - mn); *(LAS float*)(lds + CCOFF + cc * 4) = __expf(p63 + bt - mn); }
#pragma unroll
            for (int q = 0; q < 4; ++q) if (cc == 4 * w + q) mpq[q] = m;
            m = mn; }
    }
#pragma unroll
    for (int q = 0; q < 4; ++q) { const int p = ((4 * w + q) * 64 + lane) * 4; const float g = fmaxf(mpq[q], pmq[q]), p63 = lane_get(pmq[q], 63);
        *(LAS float*)(lds + EGOFF + p) = __builtin_amdgcn_exp2f(fminf((p63 - g) * LOG2E - 3.0f, 120.0f)); *(LAS float*)(lds + SJOFF + p) = __expf(mpq[q] - g) * 0.125f;
        *(LAS float*)(lds + EOFF + p) = __expf(-(bsq[q] + g)); *(LAS float*)(lds + EUOFF + p) = __expf(uq[q] - p63); }
    __syncthreads();
    {   bf16_t* kb = qkm + t0 * 512 + h * 128 + 64;
#pragma unroll 4
        for (int i = 0; i < 32; ++i) { const int idx = tid + NTHREADS * i, row = idx >> 3, pc = idx & 7; u32x4* p = (u32x4*)(kb + (size_t)row * 512 + pc * 8); const u32x4 v = *p; const float e = *(const LAS float*)(lds + EUOFF + row * 4); u32x4 o;
#pragma unroll
            for (int k4 = 0; k4 < 4; ++k4) o[k4] = cvtpk_bf16(bflo(v[k4]) * e, bfhi(v[k4]) * e);
            *p = o; }
    }
    asm volatile("s_waitcnt vmcnt(0)" ::: "memory");
    __syncthreads();
    ML_DMA(0, 0);
    f32x16 Cacc;
#pragma unroll
    for (int r = 0; r < 16; ++r) Cacc[r] = 0.f;
    for (int ch = 0; ch < NCHUNK; ++ch) {
        const int buf = ch & 1;
        if (ch == 0) asm volatile("s_waitcnt vmcnt(0)" ::: "memory");
        __syncthreads();
        if (ch > 0) ML_YSTORE(ch - 1);
        if (ch + 1 < NCHUNK) ML_DMA(ch + 1, buf ^ 1);
        ML_DMA_O(ch);
        const float sold = *(const LAS float*)(lds + SOOFF + ch * 4), cch = *(const LAS float*)(lds + CCOFF + ch * 4);
        const float egj = *(const LAS float*)(lds + EGOFF + (ch * 64 + j) * 4), sj = *(const LAS float*)(lds + SJOFF + (ch * 64 + j) * 4), ej = *(const LAS float*)(lds + EOFF + (ch * 64 + j) * 4);
        const LAS unsigned char* Qb = lds + buf * BUFB + j * QP + hi * 16;
        const LAS unsigned char* Kb = lds + buf * BUFB + KOFF + c32 * QP + hi * 16;
        const LAS unsigned char* Vb = lds + buf * BUFB + VOFF + vrd;
        const LAS unsigned char* Cb = lds + COFF + crd;
        const LAS unsigned char* Kt = lds + buf * BUFB + KOFF + krd;
        bf16x8_t qf[4], kf0[4], kf1[4], vf[4], cf[4], kt[4];

#pragma unroll
        for (int ks = 0; ks < 4; ++ks) { qf[ks] = *(const LAS bf16x8_t*)(Qb + ks * 32); kf0[ks] = *(const LAS bf16x8_t*)(Kb + ks * 32); kf1[ks] = *(const LAS bf16x8_t*)(Kb + 32 * QP + ks * 32); }
        const unsigned cba = (unsigned)(size_t)Cb, vba = (unsigned)(size_t)Vb, kta = (unsigned)(size_t)Kt;
        s16x4_t cl0, cl1, cl2, cl3, ch0, ch1, ch2, ch3;
        TR_READ(cl0, cba, 0 * VP); TR_READ(ch0, cba, 4 * VP); TR_READ(cl1, cba, 16 * VP); TR_READ(ch1, cba, 20 * VP); TR_READ(cl2, cba, 32 * VP); TR_READ(ch2, cba, 36 * VP); TR_READ(cl3, cba, 48 * VP); TR_READ(ch3, cba, 52 * VP);
        float nsp = 0.f;
        { const LAS unsigned short* kc = (const LAS unsigned short*)(lds + buf * BUFB + KOFF + (8 * w) * QP) + lane;
#pragma unroll
          for (int r = 0; r < 8; ++r) nsp += bf2f(kc[r * (QP / 2)]); }
        TR_WAIT();
        cf[0] = TR_PACK(cl0, ch0); cf[1] = TR_PACK(cl1, ch1); cf[2] = TR_PACK(cl2, ch2); cf[3] = TR_PACK(cl3, ch3);
        f32x16 pS[2], Hint;
#pragma unroll
        for (int r = 0; r < 16; ++r) { pS[0][r] = 0.f; pS[1][r] = 0.f; Hint[r] = 0.f; }
#pragma unroll
        for (int ks = 0; ks < 4; ++ks) {
            pS[0] = __builtin_amdgcn_mfma_f32_32x32x16_bf16(kf0[ks], qf[ks], pS[0], 0, 0, 0);
            pS[1] = __builtin_amdgcn_mfma_f32_32x32x16_bf16(kf1[ks], qf[ks], pS[1], 0, 0, 0);
            Hint = __builtin_amdgcn_mfma_f32_32x32x16_bf16(cf[ks], qf[ks], Hint, 0, 0, 0);
        }
        __builtin_amdgcn_sched_barrier(0);
        s16x4_t vl0, vl1, vl2, vl3, vh0, vh1, vh2, vh3;
        TR_READ(vl0, vba, 0 * VP); TR_READ(vh0, vba, 8 * VP); TR_READ(vl1, vba, 16 * VP); TR_READ(vh1, vba, 24 * VP); TR_READ(vl2, vba, 32 * VP); TR_READ(vh2, vba, 40 * VP); TR_READ(vl3, vba, 48 * VP); TR_READ(vh3, vba, 56 * VP);
        *(LAS float*)(lds + NPOFF + (w * 64 + lane) * 4) = nsp;
        float qn = 0.f;
#pragma unroll
        for (int ks = 0; ks < 4; ++ks) { const u32x4 qw = __builtin_bit_cast(u32x4, qf[ks]); const f32x4 n0 = *(const LAS f32x4*)(lds + NOFF + (16 * ks + 8 * hi) * 4), n1 = *(const LAS f32x4*)(lds + NOFF + (16 * ks + 8 * hi + 4) * 4);
            qn += (bflo(qw[0]) * n0[0] + bfhi(qw[0]) * n0[1]) + (bflo(qw[1]) * n0[2] + bfhi(qw[1]) * n0[3]) + (bflo(qw[2]) * n1[0] + bfhi(qw[2]) * n1[1]) + (bflo(qw[3]) * n1[2] + bfhi(qw[3]) * n1[3]); }
        s16x4_t kl0, kl1, kl2, kl3, kh0, kh1, kh2, kh3;
        TR_READ(kl0, kta, 0 * QP); TR_READ(kh0, kta, 8 * QP); TR_READ(kl1, kta, 16 * QP); TR_READ(kh1, kta, 24 * QP); TR_READ(kl2, kta, 32 * QP); TR_READ(kh2, kta, 40 * QP); TR_READ(kl3, kta, 48 * QP); TR_READ(kh3, kta, 56 * QP);
        TR_WAIT();
        vf[0] = TR_PACK(vl0, vh0); vf[1] = TR_PACK(vl1, vh1); vf[2] = TR_PACK(vl2, vh2); vf[3] = TR_PACK(vl3, vh3);
        kt[0] = TR_PACK(kl0, kh0); kt[1] = TR_PACK(kl1, kh1); kt[2] = TR_PACK(kl2, kh2); kt[3] = TR_PACK(kl3, kh3);
        float psum = 0.f;
#pragma unroll
        for (int r = 0; r < 16; ++r) { const int sl = (r & 3) + 8 * (r >> 2) + 4 * hi; const bool up = sl > c32;
            pS[0][r] = (x == 0 && up) ? 0.f : pS[0][r]; pS[1][r] = (x == 0 || up) ? 0.f : pS[1][r]; psum += pS[0][r] + pS[1][r]; }
        f32x16 Hacc;
#pragma unroll
        for (int r = 0; r < 16; ++r) Hacc[r] = 0.f;
#pragma unroll
        for (int ks = 0; ks < 4; ++ks) { u32x4 pw;
#pragma unroll
            for (int i = 0; i < 4; ++i) pw[i] = cvtpk_bf16(pS[ks >> 1][8 * (ks & 1) + 2 * i], pS[ks >> 1][8 * (ks & 1) + 2 * i + 1]);
            Hacc = __builtin_amdgcn_mfma_f32_32x32x16_bf16(vf[ks], __builtin_bit_cast(bf16x8_t, pw), Hacc, 0, 0, 0); }
        f32x16 Ct;
#pragma unroll
        for (int r = 0; r < 16; ++r) Ct[r] = 0.f;
#pragma unroll
        for (int ks = 0; ks < 4; ++ks) Ct = __builtin_amdgcn_mfma_f32_32x32x16_bf16(vf[ks], kt[ks], Ct, 0, 0, 0);
        f32x4 mgl[4];
#pragma unroll
        for (int r4 = 0; r4 < 4; ++r4) mgl[r4] = *(const f32x4*)(mg + h * 128 + 32 * dvb + 8 * r4 + 4 * hi);
#pragma unroll
        for (int r = 0; r < 16; ++r) Cacc[r] = Cacc[r] * sold + Ct[r] * cch;
        const float den = xhalf_sum(sj * qn + egj * psum), rden = __builtin_amdgcn_rcpf(fmaxf(fabsf(den), ej)), ea = egj * rden, sa = sj * rden;
        float ssp = 0.f;
#pragma unroll
        for (int r = 0; r < 16; ++r) { Hacc[r] = Hacc[r] * ea + Hint[r] * sa; ssp += Hacc[r] * Hacc[r]; }
        ssp = xhalf_sum(ssp);
        if (hi == 0) *(LAS float*)(lds + SSOFF + (dvb * 64 + j) * 4) = ssp;
        const float nold = *(const LAS float*)(lds + NOFF + j * 4);
        asm volatile("s_waitcnt vmcnt(0)" ::: "memory");
        __syncthreads();
        LAS unsigned char* Cw = lds + COFF + j * VP + (32 * dvb + 4 * hi) * 2;
#pragma unroll
        for (int r4 = 0; r4 < 4; ++r4) { u32x2 wv; wv.x = cvtpk_bf16(Cacc[4 * r4], Cacc[4 * r4 + 1]); wv.y = cvtpk_bf16(Cacc[4 * r4 + 2], Cacc[4 * r4 + 3]); *(LAS u32x2*)(Cw + 16 * r4) = wv; }
        if (dvb == 0 && hi == 0) { float ns = 0.f;
#pragma unroll
            for (int r = 0; r < 8; ++r) ns += *(const LAS float*)(lds + NPOFF + (r * 64 + j) * 4);
            *(LAS float*)(lds + NOFF + j * 4) = sold * nold + cch * ns; }
        const float tot = (*(const LAS float*)(lds + SSOFF + j * 4) + *(const LAS float*)(lds + SSOFF + (64 + j) * 4)) + (*(const LAS float*)(lds + SSOFF + (128 + j) * 4) + *(const LAS float*)(lds + SSOFF + (192 + j) * 4));
        const float rs = rsqrtf(tot * (1.0f / 128.0f) + EPS);
        const LAS unsigned char* ot = lds + OTOFF + j * OP + (32 * dvb + 4 * hi) * 2; LAS unsigned char* yt = lds + YTOFF + j * OP + (32 * dvb + 4 * hi) * 2;
#pragma unroll
        for (int r4 = 0; r4 < 4; ++r4) { const f32x4 g4 = mgl[r4] * rs; const u32x2 og = *(const LAS u32x2*)(ot + 16 * r4);
            u32x2 wv; wv.x = cvtpk_bf16(Hacc[4 * r4] * g4[0] * bflo(og.x), Hacc[4 * r4 + 1] * g4[1] * bfhi(og.x)); wv.y = cvtpk_bf16(Hacc[4 * r4 + 2] * g4[2] * bflo(og.y), Hacc[4 * r4 + 3] * g4[3] * bfhi(og.y));
            *(LAS u32x2*)(yt + 16 * r4) = wv; }
    }
    __syncthreads();
    ML_YSTORE(NCHUNK - 1);
#undef ML_DMA
#undef ML_DMA_O
#undef ML_YSTORE
    __syncthreads();
}
__device__ __forceinline__ int queue_next(const Ctx& c, unsigned* head) {
    __syncthreads();
    if (c.tid == 0) *(volatile LAS unsigned*)(c.lds + QSLOT_OFF) = __hip_atomic_fetch_add(head, 1u, __ATOMIC_RELAXED, __HIP_MEMORY_SCOPE_AGENT);
    __syncthreads();
    return __builtin_amdgcn_readfirstlane((int)*(volatile LAS unsigned*)(c.lds + QSLOT_OFF));
}

__device__ __forceinline__ unsigned char* opq_ws(unsigned char* p) { asm volatile("" : "+s"(p)); return p; }
__device__ __forceinline__ bool fresh(Ctx& c) { const int t = opaque_tid(c.wave); c.tid = t; c.lane = t & 63;
    int w = blockIdx.x, n = gridDim.x; asm volatile("" : "+s"(w), "+s"(n)); c.wg = w; c.nwg = n; c.ng = (n % 16 == 0) ? 8 : 1; c.g = w % c.ng; return true; }
constexpr int PH_PRO = 1, PH_PER_LAYER = 8, PH_TOTAL = PH_PRO + NL * PH_PER_LAYER;
__global__ void __launch_bounds__(NTHREADS, 2) fwd(Args a) {
    extern __shared__ __attribute__((aligned(16))) unsigned char lds_raw[];
    Ctx c; c.lds = (LAS unsigned char*)lds_raw; c.tid = threadIdx.x; c.lane = c.tid & 63; c.wave = __builtin_amdgcn_readfirstlane(c.tid >> 6); c.wg = blockIdx.x; c.nwg = gridDim.x; c.ng = 1; c.g = 0;
    volatile LAS unsigned* MISC = (volatile LAS unsigned*)(c.lds + MISC_OFF);
    for (int u = c.tid; u < (LDS_BYTES - LDSCTL_OFF) / 4; u += NTHREADS) ((LAS unsigned*)(c.lds + LDSCTL_OFF))[u] = 0u;
    __syncthreads();
    XcdBarrier bar; bar.bar = (unsigned*)(a.ws + WS_CTL) + CW_BAR; bar.x = 0; bar.st = nullptr;
    if (N_LAUNCHES == 1) { bar = xcd_barrier_post((unsigned*)(a.ws + WS_CTL) + CW_BAR, MISC + 8);
        if (threadIdx.x == 0 && (gridDim.x % 16 != 0 || bar.x != blockIdx.x % 8)) (void)xb_add((unsigned*)(a.ws + WS_CTL) + CW_MIS, 1u); }
    const int lo = a.ph_lo, hi = a.ph_hi;
    bool xcd_local = false;
#define WS(off) (opq_ws(a.ws) + (off))
#define INP(i) ((const float*)in_ptr(a, (i)))
#define INL(i, stride) (INP(i) + (size_t)l * (stride))
#define XB ((bf16_t*)WS(WS_XB))
#define XSSQ ((float*)WS(WS_XSSQ))
#define GATES ((float*)WS(WS_GATES))
#define RSCQ ((float*)WS(WS_RSCQ))
#define RSCKV ((float*)WS(WS_RSCKV))
#define KR ((bf16_t*)WS(WS_KR))
#define MEMB ((bf16_t*)WS(WS_MEMB))
#define MEMSSQ ((float*)WS(WS_MEMSSQ))
#define KVX(l) ((bf16_t*)WS(WS_KVX) + (size_t)(l) * 1024)
#define GOFF(total_, flat_, ld_) ((size_t)c.g * ((size_t)(total_) / c.ng) + (size_t)(flat_) / c.ng - (size_t)c.g * (T / c.ng) * (ld_) * 2)
#define YMIX ((bf16_t*)WS(WS_YMIX))
#define UC ((bf16_t*)(WS(WS_YMIX) + GOFF(64 * MiB, 0, 512)))
#define PROJ ((bf16_t*)(WS(WS_PROJ) + GOFF(272 * MiB, 0, NPROJ)))
#define QKM ((bf16_t*)(WS(WS_PROJ) + GOFF(272 * MiB, 128 * MiB, 512)))
#define QA ((bf16_t*)(WS(WS_PROJ) + GOFF(272 * MiB, 160 * MiB, 768)))
#define KV ((bf16_t*)(WS(WS_PROJ) + GOFF(272 * MiB, 208 * MiB, 1024)))
#define QX ((bf16_t*)(WS(WS_PROJ) + GOFF(272 * MiB, 0, 512)))
#define OX ((bf16_t*)(WS(WS_PROJ) + GOFF(272 * MiB, 32 * MiB, 512)))
#define HFF ((bf16_t*)(WS(WS_PROJ) + GOFF(272 * MiB, 0, DFF)))
#define COSB ((float*)WS(WS_COS))
#define SINB ((float*)WS(WS_SIN))
#define WT(l, off) ((bf16_t*)(WS(WS_W) + (size_t)(l) * W_LAYER + (off)))

#define FGEMM(EpiT, Eobj, Aptr, lda_, Bptr, ldb_, M_, N_, K_) FGEMMP(EpiT, Eobj, Aptr, lda_, Bptr, ldb_, M_, N_, K_, 0)
#define FGEMMP(EpiT, Eobj, Aptr, lda_, Bptr, ldb_, M_, N_, K_, APN_) FGEMMR(EpiT, Eobj, Aptr, lda_, Bptr, ldb_, M_, N_, K_, APN_, 0, pg8::WGM)
#define FGEMMR(EpiT, Eobj, Aptr, lda_, Bptr, ldb_, M_, N_, K_, APN_, ROT_, WGM_) do { const pg8::Gemm g_{Aptr, Bptr, M_, N_, K_, lda_, ldb_, (size_t)(APN_)}; pg8::StaticOrder S_; S_.init(M_, N_, c.nwg, (c.wg + (ROT_)) % c.nwg, WGM_); \
        pg8::gemm_phase<EpiT, pg8::StaticOrder, true, true>(c.lds, g_, S_, Eobj, c.wave); } while (0)
    typedef pg8::EpiBf16S<0, 1> EpiN; typedef pg8::EpiBf16S<0, 3> EpiV; typedef pg8::EpiBf16S<1, 1> EpiF;
  for (int ph = lo; ph < hi; ++ph) {
    fresh(c);
    if (ph == 0) {
        constexpr int NI[10] = {1024, 96, 64, 512, 256, 512, 256, 2048, 2048, 32}, PER_LAYER = 6848;
        LAS float* scr = (LAS float*)(c.lds + c.wave * 16384);
        const int gw = c.wg * NWAVES + c.wave, NGW = c.nwg * NWAVES;
        for (int it0 = gw; it0 < NL * PER_LAYER; it0 += NGW) {
            const int l = it0 / PER_LAYER; int it = it0 % PER_LAYER, m = 0;
#pragma unroll
            for (int q = 0; q < 9; ++q) if (m == q && it >= NI[q]) { it -= NI[q]; m = q + 1; }
            WDesc d; d.kind = 0; d.row_off = 0; d.kcol0 = 0; d.g = nullptr;
            if (m == 0)      { d.W = INL(4, 1024 * IN_COLS); d.g = INL(3, 1024); d.Wt = WT(l, WO_IN); d.K = 1024; d.N = IN_COLS; d.Npad = NPROJ; d.kind = 1; d.ldw = 1024; }
            else if (m == 1) { d.W = INL(14, 256 * 768); d.g = INL(12, 256); d.Wt = WT(l, WO_UQ); d.K = 256; d.N = 768; d.Npad = 768; d.ldw = 256; }
            else if (m == 2) { d.W = INL(15, 128 * 1024); d.g = INL(13, 128); d.Wt = WT(l, WO_UKV); d.K = 128; d.N = 1024; d.Npad = 1024; d.kind = 2; d.ldw = 256; d.kcol0 = 128; }
            else if (m == 3) { d.W = INL(19, 1024 * 1024); d.Wt = WT(l, WO_OUT); d.K = 1024; d.N = 1024; d.Npad = 1024; d.ldw = 1024; }
            else if (m == 4) { d.W = INL(22, 1024 * 512); d.g = INL(20, 1024); d.Wt = WT(l, WO_QX); d.K = 1024; d.N = 512; d.Npad = 512; d.ldw = 1024; }
            else if (m == 5) { d.W = INL(23, 1024 * 1024); d.g = INL(21, 1024); d.Wt = (bf16_t*)WS(WS_WKVX) + (size_t)l * 1024 * 1024; d.K = 1024; d.N = 1024; d.Npad = 1024; d.ldw = 1024; }
            else if (m == 6) { d.W = INL(26, 512 * 1024); d.Wt = WT(l, WO_OX); d.K = 512; d.N = 1024; d.Npad = 1024; d.ldw = 512; }
            else if (m == 7) { d.W = INL(28, 1024 * 4096); d.g = INL(27, 1024); d.Wt = WT(l, WO_FF1); d.K = 1024; d.N = 4096; d.Npad = 4096; d.ldw = 1024; }
            else if (m == 8) { d.W = INL(29, 4096 * 1024); d.Wt = WT(l, WO_FF2); d.K = 4096; d.N = 1024; d.Npad = 1024; d.ldw = 4096; }
            else { const int sub = it >> 2, hh = sub >> 1, isk = sub & 1; it &= 3;
                   d.W = INL(isk ? 8 : 7, 4 * 8192) + hh * 8192; d.Wt = WT(l, WO_QK); d.K = 128; d.N = 64; d.Npad = 64; d.ldw = 256; d.row_off = hh * 128 + isk * 64; d.kcol0 = (hh & 1) * 128; }
            conv_item(scr, c.lane, d, it);
        }
        for (int l = 0; l < NL; ++l) {
            const size_t gt = (size_t)c.wg * NTHREADS + c.tid, GT = (size_t)c.nwg * NTHREADS;
            u32x4* zk = (u32x4*)WT(l, WO_UKV);
            for (size_t i = gt; i < 1024 * 16; i += GT) zk[(i >> 4) * 32 + (i & 15)] = (u32x4){0u, 0u, 0u, 0u};
            u32x4* zq = (u32x4*)WT(l, WO_QK);
            for (size_t i = gt; i < 512 * 16; i += GT) { const int row = (int)(i >> 4), chn = (int)(i & 15); zq[(size_t)row * 32 + ((((row >> 7) & 1) ^ 1) << 4) + chn] = (u32x4){0u, 0u, 0u, 0u}; }
        }
        rows_to_bf16_ssq(c, INP(0), XB, XSSQ, T);
        rows_to_bf16_ssq(c, INP(1), MEMB, MEMSSQ, TM);
        rope_tables(c, (const int*)INP(2), COSB, SINB);
    }
    else {
        const int l = (ph - PH_PRO) / PH_PER_LAYER, k = (ph - PH_PRO) % PH_PER_LAYER;
        if (k == 0 || k == 1 || k == 4) {
            const int ng = k == 1 ? (l == 0 ? 4 : 3) : 1;
            if (k == 1) {
                kr_prep(c, PROJ, INL(17, 192), COSB, SINB, (const float*)WS(WS_RSKR), KR);
                pg8::StaticOrder So; So.init(T, 512, c.nwg, c.wg); pg8::Unit uo;
                for (int ui = 0; So.next(ui, uo); ++ui) conv_slab(c, uo.pm, uo.pn, PROJ, INL(5, 4 * 512), INL(6, 512), UC);
                asm volatile("s_waitcnt vmcnt(0)" ::: "memory"); __syncthreads(); }
            for (int gi = 0; gi < ng; ++gi) {
                fresh(c);
                const int sel = k == 0 ? 0 : k == 4 ? 1 : 2 + gi;
                bf16_t* O_ = sel == 0 ? PROJ : sel == 1 ? QX : sel == 2 ? QKM : sel == 3 ? KV : sel == 4 ? QA : (bf16_t*)WS(WS_KVX);
                const bf16_t* A_ = sel <= 1 ? XB : sel == 2 ? UC : sel == 3 ? PROJ + (PC_CKV - 128) : sel == 4 ? PROJ + PC_CQ : MEMB;
                const bf16_t* B_ = sel == 5 ? (bf16_t*)WS(WS_WKVX) : WT(l, sel == 0 ? WO_IN : sel == 1 ? WO_QX : sel == 2 ? WO_QK : sel == 3 ? WO_UKV : WO_UQ);
                const int N_ = sel == 0 ? NPROJ : sel == 1 ? 512 : sel == 2 ? 512 : sel == 3 ? 1024 : sel == 4 ? 768 : NL * 1024, K_ = (sel <= 1 || sel == 5) ? 1024 : 256,
                          lda_ = (sel <= 1 || sel == 5) ? 1024 : sel == 2 ? 512 : NPROJ, M_ = sel == 5 ? TM : T;
                float* G_ = sel == 0 ? GATES : nullptr; const float* R_ = sel <= 1 ? XSSQ : sel == 3 ? RSCKV : sel == 4 ? RSCQ : MEMSSQ; const int rm_ = (sel <= 1 || sel == 5) ? 1 : sel == 2 ? 0 : sel == 3 ? 5 : 4;
                const float* HG_ = sel == 3 ? INL(17, 192) : sel == 5 ? INP(25) : nullptr;
                asm volatile("" : "+s"(O_), "+s"(A_), "+s"(B_), "+s"(G_), "+s"(R_), "+s"(HG_));
                const EpiV E{O_, N_, R_, G_, INL(9, 4), INL(10, 4), rm_, (float*)RSCQ, (float*)RSCKV, (float*)WS(WS_RSKR), HG_, 128, (LAS float*)(c.lds + 131072)};
                FGEMMR(EpiV, E, A_, lda_, B_, K_, M_, N_, K_, sel == 2 ? 512 : 0, sel == 5 ? c.nwg / 2 : 0, sel == 5 ? 2 : pg8::WGM); }
            if (k == 4) {
                asm volatile("s_waitcnt vmcnt(0)" ::: "memory"); __syncthreads(); fresh(c);
                pg8::StaticOrder So; So.init(T, 512, c.nwg, c.wg); pg8::Unit uo;
                for (int ui = 0; So.next(ui, uo); ++ui)
                    for (int hh = 0; hh < 2; ++hh)
                        attn_block<128, false, false>(c, uo.pm >> 3, 2 * uo.pn + hh, uo.pm & 7, QX, 512, KVX(l), NL * 1024, nullptr, KVX(l) + 512, NL * 1024, NMEM, OX, 512, 0, nullptr, INL(24, 128), nullptr, nullptr, QSCALE_X); } }
        else if (k == 3 || k == 5 || k == 7) {
            const bf16_t* A_ = k == 3 ? YMIX : k == 5 ? OX : HFF; const int K_ = k == 3 ? 1024 : k == 5 ? 512 : DFF;
            const bf16_t* B_ = WT(l, k == 3 ? WO_OUT : k == 5 ? WO_OX : WO_FF2); float* of_ = (k == 7 && l == NL - 1) ? a.out : nullptr;
            asm volatile("" : "+s"(A_), "+s"(B_), "+s"(of_));
            const pg8::EpiResidB E{XB, XSSQ, of_}; FGEMM(pg8::EpiResidB, E, A_, K_, B_, K_, T, 1024, K_); }
        else if (k == 2) {
            for (;;) { const int item = queue_next(c, (unsigned*)WS(WS_CTL) + CW_Q + 64 * (l * 8 + c.g)); const int nbh = 64 / c.ng;
                if (item >= 9 * nbh) break;
                fresh(c);
                if (item < nbh) mlstm_unit(c, c.g * nbh + item, QKM, PROJ, GATES, INL(11, 512), YMIX);
                else { const int idx = item - nbh, qb = 7 - idx / nbh, bh = c.g * nbh + idx % nbh; attn_block<192, true, true>(c, bh >> 2, bh & 3, qb, QA, 768, KV, 1024, KR, KV + 512, 1024, SEQ, YMIX, D, 512, INL(18, 512), INL(16, 192), COSB, SINB, QSCALE_A); } }
            }
        else if (k == 6) { const EpiF E{HFF, DFF, XSSQ, nullptr, nullptr, nullptr, 1, nullptr, nullptr, nullptr, nullptr, 0, nullptr}; FGEMM(EpiF, E, XB, 1024, WT(l, WO_FF1), 1024, T, DFF, 1024); }
    }
    if (ph + 1 < hi) { xcd_barrier(bar, !xcd_local);
        if (ph == 0) xcd_local = __builtin_amdgcn_readfirstlane((int)xb_ld((unsigned*)WS(WS_CTL) + CW_MIS)) == 0; }
  }
}

extern "C" void kernel_launch(void* const* d_in, const int* in_sizes, int n_in, void* d_out, int out_size, void* d_ws, size_t ws_size, hipStream_t stream) {
    static int grid = 0;
    if (grid == 0) {
        int dev = 0, cus = 0, per_cu = 0;
        if (n_in != 30 || out_size != T * D || ws_size < WS_END) { fprintf(stderr, "kernel_launch: unexpected problem (n_in %d, out %d, ws %zu < %zu)\n", n_in, out_size, ws_size, (size_t)WS_END); grid = -1; return; }
        if (hipGetDevice(&dev) != hipSuccess || hipDeviceGetAttribute(&cus, hipDeviceAttributeMultiprocessorCount, dev) != hipSuccess) { fprintf(stderr, "kernel_launch: device query failed\n"); grid = -1; return; }
        if (hipFuncSetAttribute((const void*)fwd, hipFuncAttributeMaxDynamicSharedMemorySize, LDS_BYTES) != hipSuccess) { fprintf(stderr, "kernel_launch: hipFuncSetAttribute failed\n"); grid = -1; return; }
        if (hipOccupancyMaxActiveBlocksPerMultiprocessor(&per_cu, (const void*)fwd, NTHREADS, LDS_BYTES) != hipSuccess || per_cu < 1) { fprintf(stderr, "kernel_launch: occupancy query says %d blocks/CU\n", per_cu); }
        (void)hipGetLastError();
        grid = cus;
    }
    if (grid < 0) return;
    (void)hipMemsetAsync((char*)d_ws + WS_CTL, 0, CTL_ZERO_BYTES, stream);
    Args a{};
    for (int i = 0; i < 30; ++i) a.in[i] = d_in[i];
    a.out = (float*)d_out; a.ws = (unsigned char*)d_ws;
#ifdef PROBE_X
    a.ph_lo = 0; a.ph_hi = PROBE_X; hipLaunchKernelGGL(fwd, dim3(grid), dim3(NTHREADS), LDS_BYTES, stream, a);
    (void)hipMemsetAsync((char*)d_ws + WS_CTL, 0, CTL_ZERO_BYTES, stream);
#endif
    if (N_LAUNCHES == 1) { a.ph_lo = 0; a.ph_hi = PH_TOTAL; hipLaunchKernelGGL(fwd, dim3(grid), dim3(NTHREADS), LDS_BYTES, stream, a); }
    else for (int p = 0; p < PH_TOTAL; ++p) { a.ph_lo = p; a.ph_hi = p + 1; hipLaunchKernelGGL(fwd, dim3(grid), dim3(NTHREADS), LDS_BYTES, stream, a); }
}
```

```cpp
#include <hip/hip_runtime.h>
#include <cstdio>
#include <cstdint>

#ifndef N_LAUNCHES
#define N_LAUNCHES 1
#endif

#define GAS __attribute__((address_space(1)))
#define LAS __attribute__((address_space(3)))
typedef unsigned short bf16_t;
typedef GAS unsigned gu32;
typedef float f32x4 __attribute__((ext_vector_type(4)));
typedef unsigned u32x4 __attribute__((ext_vector_type(4)));
typedef unsigned u32x2 __attribute__((ext_vector_type(2)));

constexpr int BATCH = 16, SEQ = 2048, D = 1024, T = BATCH * SEQ, NL = 2;
constexpr int NMEM = 256, TM = BATCH * NMEM;
constexpr int IN_COLS = 1992, NPROJ = 2048;
constexpr int PC_U = 0, PC_V = 512, PC_O = 1024, PC_CQ = 1536, PC_CKV = 1792, PC_KR = 1920, PC_G = 1984;
constexpr int DFF = 4096;
constexpr float EPS = 1e-6f;
constexpr float LOG2E = 1.4426950408889634f;
constexpr float QSCALE_A = 0.07216878364870322f * LOG2E;
constexpr float QSCALE_X = 0.08838834764831845f * LOG2E;

constexpr size_t MiB = 1u << 20;
constexpr size_t WS_CTL = 0, CTL_ZERO_BYTES = 1 * MiB;
constexpr size_t WS_W = 2 * MiB, W_LAYER = 26 * MiB;
constexpr size_t WO_IN = 0, WO_UQ = 4 * MiB, WO_UKV = 5 * MiB  , WO_QK = 5 * MiB + 512 * 1024  , WO_OUT = 6 * MiB, WO_QX = 8 * MiB,
                 WO_OX = 9 * MiB, WO_FF1 = 10 * MiB, WO_FF2 = 18 * MiB;
constexpr size_t WS_WKVX = WS_W + 2 * W_LAYER;
constexpr size_t WS_COS = 498 * MiB, WS_SIN = 502 * MiB;
constexpr size_t WS_XB = 64 * MiB;
constexpr size_t WS_XSSQ = 128 * MiB;
constexpr size_t WS_GATES = 130 * MiB;
constexpr size_t WS_RSCQ = 131 * MiB, WS_RSCKV = WS_RSCQ + 512 * 1024, WS_RSKR = 145 * MiB;
constexpr size_t WS_KR = 132 * MiB;
constexpr size_t WS_MEMB = 136 * MiB;
constexpr size_t WS_MEMSSQ = 144 * MiB;
constexpr size_t WS_KVX = 146 * MiB;
constexpr size_t WS_YMIX = 162 * MiB;
constexpr size_t WS_PROJ = 226 * MiB;
constexpr size_t WS_QKM = 354 * MiB;
constexpr size_t WS_QA = 386 * MiB;
constexpr size_t WS_KV = 434 * MiB;
constexpr size_t WS_END = 506 * MiB;
constexpr size_t WS_QX = 226 * MiB, WS_OX = 258 * MiB;
constexpr size_t WS_HFF = 226 * MiB;
constexpr int CW_BAR = 4096, CW_Q = 8192, CW_MIS = 12288;

__device__ __forceinline__ float bf2f(unsigned v) { return __uint_as_float(v << 16); }
__device__ __forceinline__ float bflo(unsigned w) { return __uint_as_float(w << 16); }
__device__ __forceinline__ float bfhi(unsigned w) { return __uint_as_float(w & 0xffff0000u); }
__device__ __forceinline__ unsigned f2bf(float f) { unsigned u = __float_as_uint(f); return (u + 0x7fffu + ((u >> 16) & 1u)) >> 16; }
__device__ __forceinline__ unsigned pk2(float lo, float hi) { return f2bf(lo) | (f2bf(hi) << 16); }
__device__ __forceinline__ float shx(float v, int mask, int lane) { return __int_as_float(__builtin_amdgcn_ds_bpermute((lane ^ mask) << 2, __float_as_int(v))); }
__device__ __forceinline__ float wave_sum(float v, int lane) {
#pragma unroll
    for (int o = 1; o < 64; o <<= 1) v += shx(v, o, lane);
    return v;
}
__device__ __forceinline__ float sigmoidf_(float x) { return __builtin_amdgcn_rcpf(1.0f + __builtin_amdgcn_exp2f(-1.4426950408889634f * x)); }

#define XB_TMO      128
#define XB_XCNT(j)  (256  + 64 * (j))
#define XB_XSUB(j)  (1280 + 64 * (j))
#define XB_XGEN(j)  (2304 + 64 * (j))
#define XB_TOP      3328
#define XB_TOPGEN   3392
#define XCD_BAR_WORDS 3456
#define XB_SPIN_CAP (1u << 18)
__device__ __forceinline__ unsigned xb_ld(unsigned* p)              { return __hip_atomic_load(p, __ATOMIC_RELAXED, __HIP_MEMORY_SCOPE_AGENT); }
__device__ __forceinline__ unsigned xb_add(unsigned* p, unsigned v) { return __hip_atomic_fetch_add(p, v, __ATOMIC_RELAXED, __HIP_MEMORY_SCOPE_AGENT); }
__device__ __forceinline__ unsigned xb_xcc_id() { return (unsigned)__builtin_amdgcn_s_getreg((3 << 11) | 20) & 0xFu; }
#define XB_SPIN(cond, bar) do { unsigned _sp = 0; while (cond) { __builtin_amdgcn_s_sleep(1); \
    if ((++_sp & 255u) == 0u) { if (xb_ld(&(bar)[XB_TMO])) break; if (_sp > XB_SPIN_CAP) { atomicAdd(&(bar)[XB_TMO], 1u); break; } } } } while (0)
struct XcdBarrier { unsigned* bar; unsigned x; volatile LAS unsigned* st; };
__device__ __forceinline__ XcdBarrier xcd_barrier_post(unsigned* bar, volatile LAS unsigned* st) {
    XcdBarrier b; b.bar = bar; b.x = xb_xcc_id(); b.st = st;
    if (threadIdx.x == 0) (void)xb_add(&bar[XB_XCNT(b.x)], 1u);
    return b;
}
__device__ __forceinline__ void xcd_barrier_complete(unsigned* bar, unsigned x, unsigned& nloc, unsigned& nx) {
    const unsigned G = gridDim.x * gridDim.y * gridDim.z;
    unsigned sum, cnt, mine, sp = 0u;
    for (;;) {
        sum = 0u; cnt = 0u; mine = 0u;
#pragma unroll
        for (unsigned j = 0; j < 16; ++j) { const unsigned c = xb_ld(&bar[XB_XCNT(j)]); sum += c; cnt += (c > 0u) ? 1u : 0u; mine = (j == x) ? c : mine; }
        if (sum == G) break;
        __builtin_amdgcn_s_sleep(1);
        if ((++sp & 255u) == 0u) { if (xb_ld(&bar[XB_TMO])) break; if (sp > XB_SPIN_CAP) { atomicAdd(&bar[XB_TMO], 1u); break; } }
    }
    nloc = mine > 0u ? mine : 1u; nx = cnt > 0u ? cnt : 1u;
}
__device__ __forceinline__ void xcd_barrier(const XcdBarrier& b, bool top) {
    asm volatile("s_waitcnt vmcnt(0)" ::: "memory");
    __syncthreads();
    if (threadIdx.x == 0) {
        unsigned* bar = b.bar; unsigned bx = b.x; asm volatile("" : "+s"(bar), "+s"(bx));
        __builtin_amdgcn_s_waitcnt(0);
        unsigned nloc = b.st[0], nx = b.st[1];
        if (nloc == 0u) { xcd_barrier_complete(bar, bx, nloc, nx); b.st[0] = nloc; b.st[1] = nx; }
        const unsigned old = xb_add(&bar[XB_XSUB(bx)], 1u);
        const unsigned gen = old / nloc;
        if (old + 1u == (gen + 1u) * nloc) {
            __builtin_amdgcn_fence(__ATOMIC_RELEASE, "agent");
            asm volatile("s_waitcnt vmcnt(0)" ::: "memory");
            if (top) {
                const unsigned og = xb_add(&bar[XB_TOP], 1u);
                const unsigned tg = og / nx;
                if (og + 1u == (tg + 1u) * nx) xb_add(&bar[XB_TOPGEN], 1u);
                else XB_SPIN(xb_ld(&bar[XB_TOPGEN]) == tg, bar);
            }
            __builtin_amdgcn_fence(__ATOMIC_ACQUIRE, "agent");
            xb_add(&bar[XB_XGEN(bx)], 1u);
            asm volatile("s_waitcnt vmcnt(0)" ::: "memory");
        } else {
            XB_SPIN(xb_ld(&bar[XB_XGEN(bx)]) == gen, bar);
            __builtin_amdgcn_fence(__ATOMIC_ACQUIRE, "agent");
            asm volatile("s_waitcnt vmcnt(0)" ::: "memory");
        }
    }
    __syncthreads();
}

constexpr int NWAVES = 8, NTHREADS = NWAVES * 64;
constexpr int LDS_BYTES = 163840;
constexpr int LDSCTL_OFF = LDS_BYTES - 512, MISC_OFF = LDSCTL_OFF + 320, QSLOT_OFF = LDSCTL_OFF + 448;
struct Ctx { int tid, lane, wave, wg, nwg, g, ng; LAS unsigned char* lds; };
__device__ __forceinline__ int opaque_tid(int wave) { int z = 0; asm volatile("" : "+v"(z)); return wave * 64 + (int)__builtin_amdgcn_mbcnt_hi(~0u, __builtin_amdgcn_mbcnt_lo(~0u, (unsigned)z)); }
struct Args { const void* in[30]; float* out; unsigned char* ws; int ph_lo, ph_hi; };
__device__ __forceinline__ const void* in_ptr(const Args& a, int i) { asm volatile("" : "+s"(i)); return a.in[i]; }

__device__ __forceinline__ int cmap_proj(int n) {
    if (n < PC_CQ) return n;
    if (n < PC_CKV) return 1544 + (n - PC_CQ);
    if (n < PC_KR) return 1800 + (n - PC_CKV);
    if (n < PC_G) return 1928 + (n - PC_KR);
    if (n < PC_G + 8) return 1536 + (n - PC_G);
    return -1;
}
__device__ __forceinline__ int cmap_ukv(int n) { const int part = n >> 9, h = (n >> 7) & 3, j = n & 127; return h * 256 + part * 128 + j; }
struct WDesc { const float* W; const float* g; bf16_t* Wt; int K, N, Npad, kind, row_off, ldw, kcol0; };
__device__ __forceinline__ void conv_item(LAS float* scr, int lane, const WDesc& d, int it) {
    const int nblk = d.Npad / 32, kb = it / nblk, nb = it % nblk, k0 = 64 * kb, n0 = 32 * nb;
    const int kr = lane >> 3, c4 = lane & 7, np4 = n0 + 4 * c4;
    const int src = d.kind == 1 ? cmap_proj(np4) : d.kind == 2 ? cmap_ukv(np4) : np4;
    f32x4 wv[8];
#pragma unroll
    for (int i = 0; i < 8; ++i) wv[i] = src >= 0 ? *(const f32x4*)(d.W + (size_t)(k0 + 8 * i + kr) * d.N + src) : (f32x4){0.f, 0.f, 0.f, 0.f};
    const float gl = d.g ? d.g[k0 + lane] : 1.0f;
#pragma unroll
    for (int i = 0; i < 8; ++i) { const float gg = __int_as_float(__builtin_amdgcn_ds_bpermute((8 * i + kr) << 2, __float_as_int(gl))); LAS float* q = scr + (8 * i + kr) * 33 + 4 * c4;
        q[0] = wv[i][0] * gg; q[1] = wv[i][1] * gg; q[2] = wv[i][2] * gg; q[3] = wv[i][3] * gg; }
    asm volatile("s_waitcnt lgkmcnt(0)" ::: "memory");
    const int ch = lane & 7;
#pragma unroll
    for (int j = 0; j < 4; ++j) { const int n = (lane >> 3) + 8 * j; const LAS float* s = scr + (8 * ch) * 33 + n;
        u32x4 o; o.x = pk2(s[0 * 33], s[1 * 33]); o.y = pk2(s[2 * 33], s[3 * 33]); o.z = pk2(s[4 * 33], s[5 * 33]); o.w = pk2(s[6 * 33], s[7 * 33]);
        *(u32x4*)(d.Wt + (size_t)(d.row_off + n0 + n) * d.ldw + d.kcol0 + k0 + 8 * ch) = o; }
    asm volatile("s_waitcnt lgkmcnt(0)" ::: "memory");
}
__device__ __forceinline__ void rows_to_bf16_ssq(const Ctx& c, const float* src, bf16_t* dst, float* ssq, int nrows) {
    const int gw = c.wg * NWAVES + c.wave, NGW = c.nwg * NWAVES, lane = c.lane;
    for (int r0 = gw * 4; r0 < nrows; r0 += NGW * 4) {
        f32x4 v[4][4];
#pragma unroll
        for (int q = 0; q < 4; ++q)
#pragma unroll
            for (int j = 0; j < 4; ++j) v[q][j] = ((const f32x4*)(src + (size_t)(r0 + q) * D) + lane)[64 * j];
#pragma unroll
        for (int q = 0; q < 4; ++q) { unsigned long long* o8 = (unsigned long long*)(dst + (size_t)(r0 + q) * D) + lane; float s = 0.f;
#pragma unroll
            for (int j = 0; j < 4; ++j) { const f32x4 x = v[q][j]; s += (x.x * x.x + x.y * x.y) + (x.z * x.z + x.w * x.w); o8[64 * j] = (unsigned long long)pk2(x.x, x.y) | ((unsigned long long)pk2(x.z, x.w) << 32); }
            s = wave_sum(s, lane);
            if (lane < 16) ssq[(size_t)(r0 + q) * 16 + lane] = lane == 0 ? s : 0.f; }
    }
}
__device__ __forceinline__ void rope_tables(const Ctx& c, const int* pos, float* cosb, float* sinb) {
    const size_t gt = (size_t)c.wg * NTHREADS + c.tid, GT = (size_t)c.nwg * NTHREADS;
    for (size_t i = gt; i < (size_t)T * 32; i += GT) { const int t = (int)(i >> 5), k = (int)(i & 31);
        const float inv = exp2f(-(float)k * 0.41524101186092029f);
        const float ang = (float)pos[t] * inv; float sn, cs; sincosf(ang, &sn, &cs);
        cosb[i] = cs; sinb[i] = sn; }
}

namespace pg8 {
#define PG8_LAS __attribute__((address_space(3)))
typedef unsigned short bf16_t;
typedef short bf16x8 __attribute__((ext_vector_type(8)));
typedef float f32x4 __attribute__((ext_vector_type(4)));
typedef unsigned u32x4 __attribute__((ext_vector_type(4)));
constexpr int BM = 256, BK = 64, HALF = 128, HTB = HALF * BK * 2  , STAGE_BYTES = 8 * HTB, NXCD = 8, WGM = 8;

__host__ __device__ __forceinline__ int lds_byte(int r, int c) { const int st = (r >> 4) * 2 + (c >> 5), rr = r & 15, cc = c & 31, ob = rr * 64 + cc * 2; return st * 1024 + (ob ^ (((ob >> 9) & 1) << 5)); }
__host__ __device__ __forceinline__ void stage_rc(int b, int& R, int& C) { const int st = b / 1024, sb = b % 1024, swz = sb ^ (((sb >> 9) & 1) << 5); R = (st >> 1) * 16 + swz / 64; C = (st & 1) * 32 + (swz % 64) / 2; }
__host__ __device__ __forceinline__ int perm32(int rho) { const int n = rho >> 4, i = rho & 15; return 8 * (i >> 2) + 4 * n + (i & 3); }

struct Unit { int pm, pn; };
struct Gemm { const bf16_t* A; const bf16_t* Bt; int M, N, K, lda, ldb; size_t a_pn; };

struct StaticOrder {
    int nM, nN, nwg, G, c, wgm;
    __host__ __device__ void init(int M, int N, int G_, int c_, int wgm_ = WGM) { nM = M / BM; nN = N / BM; nwg = nM * nN; G = G_; c = c_; wgm = wgm_; }
    __host__ __device__ bool next(int i, Unit& u) const {
        const long L = (long)i * G + c; if (L >= nwg) return false;
        int wgid = (int)L; { const int q = nwg / NXCD, r = nwg % NXCD, xcd = wgid % NXCD, off = wgid / NXCD; wgid = (xcd < r ? xcd * (q + 1) : r * (q + 1) + (xcd - r) * q) + off; }
        const int nig = wgm * nN, gid = wgid / nig, fm = gid * wgm, gsz = (nM - fm) < wgm ? (nM - fm) : wgm;
        u.pm = fm + ((wgid % nig) % gsz); u.pn = (wgid % nig) / gsz; return true;
    }
    __device__ __forceinline__ void a_ready(const Unit&) const {}
    __device__ __forceinline__ void done(const Unit&) const {}
};

__device__ __forceinline__ unsigned cvt_pk_bf16(float lo, float hi) { unsigned r; asm volatile("v_cvt_pk_bf16_f32 %0, %1, %2\n\ts_nop 1" : "=v"(r) : "v"(lo), "v"(hi));     return r; }
__device__ __forceinline__ float rs_ssq16(const float* ssq, int row) {
    const f32x4* p = (const f32x4*)(ssq + (size_t)row * 16); const f32x4 a = (p[0] + p[1]) + (p[2] + p[3]);
    return __builtin_amdgcn_rsqf(((a.x + a.y) + (a.z + a.w)) * (1.0f / 1024.0f) + 1e-6f);
}
template <int MODE, int RS> struct EpiBf16S {
    static constexpr bool PERM = true, AFTER_DRAIN = false;
    bf16_t* O; int ldo; const float* rsrc; float* gates; const float* bi; const float* bfg; int rsmode;
    float* st_cq; float* st_ckv; float* st_kr; const float* hgain; int hgstride; PG8_LAS float* ex;
    PG8_LAS float* rsc = nullptr;
    __device__ __forceinline__ void prepare(int pm0, int pm1, int tid) const {
        const bool m16 = RS == 1 || (RS == 3 && rsmode == 1), m4 = RS == 3 && rsmode >= 4;
        if ((m16 || m4) && rsc != nullptr) {
            const int pm = tid < 256 ? pm0 : pm1; const size_t row = (size_t)pm * BM + (tid & 255);
            if (m16) { const f32x4* p = (const f32x4*)(rsrc + row * 16); const f32x4 a = (p[0] + p[1]) + (p[2] + p[3]); rsc[tid] = __builtin_amdgcn_rsqf(((a.x + a.y) + (a.z + a.w)) * (1.0f / 1024.0f) + 1e-6f); }
            else { const f32x4 a = *(const f32x4*)(rsrc + row * 4); rsc[tid] = __builtin_amdgcn_rsqf(((a.x + a.y) + (a.z + a.w)) * (rsmode == 4 ? 1.0f / 256.0f : 1.0f / 128.0f) + 1e-6f); }
            if (tid == 0) { ((PG8_LAS int*)rsc)[512] = pm0; ((PG8_LAS int*)rsc)[513] = pm1; } }
    }
    __device__ __forceinline__ void rowscales(float (&rsv)[8], int row0, int fq, int lane, int pm) const {
        const bool m16 = RS == 1 || (RS == 3 && rsmode == 1), m4 = RS == 3 && rsmode >= 4;
        int slot = -1;
        if ((m16 || m4) && rsc != nullptr) { const int t0 = __builtin_amdgcn_readfirstlane(((const PG8_LAS int*)rsc)[512]), t1 = __builtin_amdgcn_readfirstlane(((const PG8_LAS int*)rsc)[513]); slot = pm == t0 ? 0 : pm == t1 ? 1 : -1; }
        if (slot >= 0) { const PG8_LAS float* q = rsc + slot * 256 + (row0 - pm * BM);
#pragma unroll
            for (int i = 0; i < 8; ++i) rsv[i] = q[(i >> 2) * HALF + (i & 3) * 16]; }
        else if (m16) { f32x4 p[8];
#pragma unroll
            for (int i = 0; i < 8; ++i) p[i] = *(const f32x4*)(rsrc + (size_t)(row0 + (i >> 2) * HALF + (i & 3) * 16) * 16 + 4 * fq);
#pragma unroll
            for (int i = 0; i < 8; ++i) { float s = (p[i].x + p[i].y) + (p[i].z + p[i].w); s += ::shx(s, 16, lane); s += ::shx(s, 32, lane); rsv[i] = __builtin_amdgcn_rsqf(s * (1.0f / 1024.0f) + 1e-6f); } }
        else if (m4) { float p[8]; const float inv = rsmode == 4 ? 1.0f / 256.0f : 1.0f / 128.0f;
#pragma unroll
            for (int i = 0; i < 8; ++i) p[i] = rsrc[(size_t)(row0 + (i >> 2) * HALF + (i & 3) * 16) * 4 + fq];
#pragma unroll
            for (int i = 0; i < 8; ++i) { float s = p[i]; s += ::shx(s, 16, lane); s += ::shx(s, 32, lane); rsv[i] = __builtin_amdgcn_rsqf(s * inv + 1e-6f); } }
        else {
#pragma unroll
            for (int i = 0; i < 8; ++i) rsv[i] = 1.0f; }
    }
    __device__ __forceinline__ void operator()(const f32x4 (&acc)[2][2][4][2], const Unit& u, int wr, int wc, int fr, int fq) const {
        const int row0 = u.pm * BM + wr * 64 + fr, col0 = u.pn * BM + wc * 32 + 8 * fq, lane = fq * 16 + fr;
        const bool gl = gates != nullptr && u.pn == 7 && wc == 2 && fq == 0;
        const bool st = RS == 3 && gates != nullptr && u.pn >= 6;
        const bool hn = RS == 3 && hgain != nullptr && ((u.pn >> 1) & 1) == 0;
        float rsv[8]; rowscales(rsv, row0, fq, lane, u.pm);
        if (hn) {
#pragma unroll
            for (int ai = 0; ai < 2; ++ai)
#pragma unroll
                for (int m = 0; m < 4; ++m) { const int rl = ai * HALF + wr * 64 + m * 16 + fr; const float rs = rsv[ai * 4 + m];
#pragma unroll
                    for (int bj = 0; bj < 2; ++bj) { const f32x4 v0 = acc[ai][bj][m][0] * rs, v1 = acc[ai][bj][m][1] * rs;
                        float ss = ((v0[0] * v0[0] + v0[1] * v0[1]) + (v0[2] * v0[2] + v0[3] * v0[3])) + ((v1[0] * v1[0] + v1[1] * v1[1]) + (v1[2] * v1[2] + v1[3] * v1[3]));
                        ss += ::shx(ss, 16, lane); ss += ::shx(ss, 32, lane);
                        if (fq == 0) ex[(rl * 2 + bj) * 4 + wc] = ss; } }
            asm volatile("s_waitcnt lgkmcnt(0)" ::: "memory"); __builtin_amdgcn_s_barrier(); asm volatile("" ::: "memory");
        }
        f32x4 hg0 = {1.f, 1.f, 1.f, 1.f}, hg1 = {1.f, 1.f, 1.f, 1.f};
        if (hn) { const float* gp = hgain + (u.pn >> 2) * hgstride + wc * 32 + 8 * fq; hg0 = *(const f32x4*)gp; hg1 = *(const f32x4*)(gp + 4); }
#pragma unroll
        for (int ai = 0; ai < 2; ++ai)
#pragma unroll
            for (int m = 0; m < 4; ++m) { const int row = row0 + ai * HALF + m * 16, rl = ai * HALF + wr * 64 + m * 16 + fr; bf16_t* rowp = O + (size_t)row * ldo + col0;
                const float rs = rsv[ai * 4 + m];
                float sq = 0.f;
#pragma unroll
                for (int bj = 0; bj < 2; ++bj) { f32x4 v0 = acc[ai][bj][m][0] * rs, v1 = acc[ai][bj][m][1] * rs;
                    if (bj == 1 && gl) { *(f32x4*)(gates + (size_t)row * 8) = v0 + *(const f32x4*)bi; *(f32x4*)(gates + (size_t)row * 8 + 4) = v1 + *(const f32x4*)bfg; }
                    if (RS == 3 && gates != nullptr && (u.pn == 4 || u.pn == 5)) {
#pragma unroll
                        for (int e = 0; e < 4; ++e) { v0[e] = __builtin_amdgcn_rcpf(1.0f + __builtin_amdgcn_exp2f(-1.4426950408889634f * v0[e])); v1[e] = __builtin_amdgcn_rcpf(1.0f + __builtin_amdgcn_exp2f(-1.4426950408889634f * v1[e])); } }
                    if (st) { const float s8 = ((v0[0] * v0[0] + v0[1] * v0[1]) + (v0[2] * v0[2] + v0[3] * v0[3])) + ((v1[0] * v1[0] + v1[1] * v1[1]) + (v1[2] * v1[2] + v1[3] * v1[3]));
                        if (u.pn == 6) sq += s8;
                        else { float s = s8; s += ::shx(s, 16, lane); s += ::shx(s, 32, lane); if (fq == 0) { if (bj == 0) st_ckv[(size_t)row * 4 + wc] = s; else if (wc < 2) st_kr[(size_t)row * 2 + wc] = s; } } }
                    if (hn) { const f32x4 p = *(const PG8_LAS f32x4*)(ex + (rl * 2 + bj) * 4); const float rh = __builtin_amdgcn_rsqf(((p.x + p.y) + (p.z + p.w)) * (1.0f / 128.0f) + 1e-6f); v0 = v0 * rh * hg0; v1 = v1 * rh * hg1; }
                    if (MODE == 1) { v0 = __builtin_elementwise_max(v0, (f32x4){0.f, 0.f, 0.f, 0.f}); v1 = __builtin_elementwise_max(v1, (f32x4){0.f, 0.f, 0.f, 0.f}); v0 = v0 * v0; v1 = v1 * v1; }
                    u32x4 w; w.x = cvt_pk_bf16(v0[0], v0[1]); w.y = cvt_pk_bf16(v0[2], v0[3]); w.z = cvt_pk_bf16(v1[0], v1[1]); w.w = cvt_pk_bf16(v1[2], v1[3]);
                    *(u32x4*)(rowp + bj * HALF) = w; }
                if (st && u.pn == 6) { sq += ::shx(sq, 16, lane); sq += ::shx(sq, 32, lane); if (fq == 0) st_cq[(size_t)row * 4 + wc] = sq; } }
    }
};
struct EpiResidB {
    static constexpr bool PERM = true, AFTER_DRAIN = false;
    bf16_t* xb; float* xssq; float* outf;
    __device__ __forceinline__ void prepare(int, int, int) const {}
    __device__ __forceinline__ void operator()(const f32x4 (&acc)[2][2][4][2], const Unit& u, int wr, int wc, int fr, int fq) const {
        const int row0 = u.pm * BM + wr * 64 + fr, col0 = u.pn * BM + wc * 32 + 8 * fq, lane = fq * 16 + fr;
#pragma unroll
        for (int ai = 0; ai < 2; ++ai) {
            u32x4 xin[4][2];
#pragma unroll
            for (int m = 0; m < 4; ++m)
#pragma unroll
                for (int bj = 0; bj < 2; ++bj) xin[m][bj] = *(const u32x4*)(xb + (size_t)(row0 + ai * HALF + m * 16) * 1024 + col0 + bj * HALF);
#pragma unroll
            for (int m = 0; m < 4; ++m) { const int row = row0 + ai * HALF + m * 16; const size_t off = (size_t)row * 1024 + col0; float ss = 0.f;
#pragma unroll
                for (int bj = 0; bj < 2; ++bj) { const u32x4 xw = xin[m][bj];
                    const f32x4 v0 = acc[ai][bj][m][0] + (f32x4){__uint_as_float(xw.x << 16), __uint_as_float(xw.x & 0xffff0000u), __uint_as_float(xw.y << 16), __uint_as_float(xw.y & 0xffff0000u)};
                    const f32x4 v1 = acc[ai][bj][m][1] + (f32x4){__uint_as_float(xw.z << 16), __uint_as_float(xw.z & 0xffff0000u), __uint_as_float(xw.w << 16), __uint_as_float(xw.w & 0xffff0000u)};
                    ss += ((v0[0] * v0[0] + v0[1] * v0[1]) + (v0[2] * v0[2] + v0[3] * v0[3])) + ((v1[0] * v1[0] + v1[1] * v1[1]) + (v1[2] * v1[2] + v1[3] * v1[3]));
                    u32x4 w; w.x = cvt_pk_bf16(v0[0], v0[1]); w.y = cvt_pk_bf16(v0[2], v0[3]); w.z = cvt_pk_bf16(v1[0], v1[1]); w.w = cvt_pk_bf16(v1[2], v1[3]);
                    if (outf) { *(f32x4*)(outf + off + bj * HALF) = v0; *(f32x4*)(outf + off + bj * HALF + 4) = v1; }
                    else *(u32x4*)(xb + off + bj * HALF) = w; }
                if (!outf) { ss += ::shx(ss, 16, lane); ss += ::shx(ss, 32, lane);
                    if (fq == 0) xssq[(size_t)row * 16 + u.pn * 4 + wc] = ss; } }
            asm volatile("" ::: "memory"); }
    }
};
template <class Epi, class Sched, bool ALIGN_EPI = false, bool SP2 = false>
__device__ __forceinline__ void gemm_phase(PG8_LAS unsigned char* lds, const Gemm g, const Sched& S, const Epi& E, int wave_id) {
    const int tid_ = opaque_tid(wave_id);
    int wid_ = wave_id; asm volatile("" : "+s"(wid_));
    const int tid = tid_, wid = wid_, lane = tid & 63, wr = wid >> 2, wc = wid & 3, fr = lane & 15, fq = lane >> 4;
    const int K = g.K, nt = K / BK;
    unsigned voffA[2], voffB[2];
#pragma unroll
    for (int i = 0; i < 2; ++i) { int R, C; stage_rc(tid * 16 + i * 8192, R, C); const int Rb = Epi::PERM ? ((R & ~31) + perm32(R & 31)) : R;
        voffA[i] = (unsigned)(R * g.lda + C) * 2u; voffB[i] = (unsigned)(Rb * g.ldb + C) * 2u; }
    const size_t kstep = (size_t)(BK * 2);
    const size_t hA = (size_t)HALF * g.lda * 2, hB = (size_t)HALF * g.ldb * 2;
    const size_t tA = 2 * hA, tB = 2 * hB;
    const unsigned ldsw = (unsigned)wid * 1024u;
    const int aoff = lds_byte(wr * 64 + fr, fq * 8), boff = lds_byte(wc * 32 + fr, fq * 8);
#define PG8_SA(b, h) (((b) * 2 + (h)) * HTB)
#define PG8_SB(b, h) ((4 + (b) * 2 + (h)) * HTB)
#define PG8_STAGE(bufoff, gbase, voff) do { _Pragma("unroll") for (int _i = 0; _i < 2; ++_i) \
        __builtin_amdgcn_global_load_lds((const unsigned*)((const char*)(gbase) + (voff)[_i]), (PG8_LAS unsigned*)(lds + (bufoff) + ldsw + _i * 8192), 16, 0, 0); } while (0)
#define PG8_LDA(dst, b, h) do { _Pragma("unroll") for (int m = 0; m < 4; ++m) _Pragma("unroll") for (int k = 0; k < 2; ++k) dst[m][k] = *(const PG8_LAS bf16x8*)(lds + PG8_SA(b, h) + aoff + m * 2048 + k * 1024); } while (0)
#define PG8_LDB(dst, b, h) do { _Pragma("unroll") for (int n = 0; n < 2; ++n) _Pragma("unroll") for (int k = 0; k < 2; ++k) dst[n][k] = *(const PG8_LAS bf16x8*)(lds + PG8_SB(b, h) + boff + n * 2048 + k * 1024); } while (0)
#define PG8_MMA(ai, bj, At, Bt) do { __builtin_amdgcn_s_setprio(1); _Pragma("unroll") for (int m = 0; m < 4; ++m) _Pragma("unroll") for (int n = 0; n < 2; ++n) _Pragma("unroll") for (int k = 0; k < 2; ++k) \
        acc[ai][bj][m][n] = __builtin_amdgcn_mfma_f32_16x16x32_bf16(Bt[n][k], At[m][k], acc[ai][bj][m][n], 0, 0, 0); __builtin_amdgcn_s_setprio(0); } while (0)
#define PG8_WAIT_V(n) asm volatile("s_waitcnt vmcnt(" #n ")" ::: "memory")
#define PG8_WAIT_L(n) asm volatile("s_waitcnt lgkmcnt(" #n ")" ::: "memory")
#define PG8_BAR __builtin_amdgcn_s_barrier()
#define PG8_SCHED __builtin_amdgcn_sched_barrier(0)
    Unit cur, nxt; int ui = 0;
    if (!S.next(0, cur)) return;
    f32x4 acc[2][2][4][2];
#pragma unroll
    for (int a = 0; a < 2; ++a)
#pragma unroll
        for (int b = 0; b < 2; ++b)
#pragma unroll
            for (int m = 0; m < 4; ++m)
#pragma unroll
                for (int n = 0; n < 2; ++n) acc[a][b][m][n] = (f32x4){0.f, 0.f, 0.f, 0.f};
    bf16x8 At[4][2], B0[2][2], B1[2][2];
    const char* cA = (const char*)g.A + (size_t)cur.pm * tA + (size_t)cur.pn * g.a_pn; const char* cB = (const char*)g.Bt + (size_t)cur.pn * tB;
    S.a_ready(cur);
    if constexpr (SP2) {
        PG8_STAGE(PG8_SB(0, 0), cB, voffB); PG8_STAGE(PG8_SB(0, 1), cB + hB, voffB); PG8_STAGE(PG8_SA(0, 0), cA, voffA); PG8_STAGE(PG8_SA(0, 1), cA + hA, voffA);
        { int pm1 = cur.pm; Unit q_; for (int i_ = 1; S.next(i_, q_); ++i_) if (q_.pm != cur.pm) { pm1 = q_.pm; break; }
          E.prepare(cur.pm, pm1, tid); asm volatile("s_waitcnt vmcnt(0) lgkmcnt(0)" ::: "memory"); }
        if (wr == 1) PG8_BAR;
        PG8_WAIT_V(2); PG8_BAR;
        PG8_STAGE(PG8_SB(1, 0), cB + kstep, voffB); PG8_STAGE(PG8_SA(1, 0), cA + kstep, voffA); PG8_STAGE(PG8_SB(1, 1), cB + hB + kstep, voffB);
        PG8_WAIT_V(6); PG8_BAR;
    } else {
        PG8_STAGE(PG8_SB(0, 0), cB, voffB); PG8_STAGE(PG8_SA(0, 0), cA, voffA); PG8_STAGE(PG8_SB(0, 1), cB + hB, voffB); PG8_STAGE(PG8_SA(0, 1), cA + hA, voffA);
        if (wr == 1) PG8_BAR;
        PG8_WAIT_V(4); PG8_BAR;
        PG8_STAGE(PG8_SB(1, 0), cB + kstep, voffB); PG8_STAGE(PG8_SA(1, 0), cA + kstep, voffA); PG8_STAGE(PG8_SB(1, 1), cB + hB + kstep, voffB);
        PG8_WAIT_V(6); PG8_BAR;
    }
    for (;;) {
        const bool has_next = S.next(ui + 1, nxt);
        const char* nA = has_next ? (const char*)g.A + (size_t)nxt.pm * tA + (size_t)nxt.pn * g.a_pn : cA; const char* nB = has_next ? (const char*)g.Bt + (size_t)nxt.pn * tB : cB;
        for (int t = 0; t < nt; t += 2) {
            const bool last = (t == nt - 2);
            const char* a1 = cA + (size_t)(t + 1) * kstep;
            const char* a2 = last ? nA : cA + (size_t)(t + 2) * kstep; const char* b2 = last ? nB : cB + (size_t)(t + 2) * kstep;
            const char* a3 = a2 + kstep; const char* b3 = b2 + kstep;
            if (last && has_next) S.a_ready(nxt);
            if constexpr (SP2) {
            PG8_LDB(B0, 0, 0); PG8_LDB(B1, 0, 1); PG8_SCHED; PG8_LDA(At, 0, 0); PG8_STAGE(PG8_SA(1, 1), a1 + hA, voffA);
            PG8_WAIT_V(8); PG8_WAIT_L(0); PG8_BAR; PG8_MMA(0, 0, At, B0); PG8_MMA(0, 1, At, B1); PG8_BAR; PG8_SCHED;
            PG8_LDA(At, 0, 1); PG8_STAGE(PG8_SB(0, 0), b2, voffB); PG8_STAGE(PG8_SB(0, 1), b2 + hB, voffB); PG8_STAGE(PG8_SA(0, 0), a2, voffA);
            PG8_WAIT_V(8); PG8_WAIT_L(0); PG8_BAR; PG8_MMA(1, 0, At, B0); PG8_MMA(1, 1, At, B1); PG8_BAR; PG8_SCHED;
            PG8_LDB(B0, 1, 0); PG8_LDB(B1, 1, 1); PG8_SCHED; PG8_LDA(At, 1, 0); PG8_STAGE(PG8_SA(0, 1), a2 + hA, voffA);
            PG8_WAIT_V(8); PG8_WAIT_L(0); PG8_BAR; PG8_MMA(0, 0, At, B0); PG8_MMA(0, 1, At, B1); PG8_BAR; PG8_SCHED;
            PG8_LDA(At, 1, 1); PG8_STAGE(PG8_SB(1, 0), b3, voffB); PG8_STAGE(PG8_SB(1, 1), b3 + hB, voffB); PG8_STAGE(PG8_SA(1, 0), a3, voffA);
            PG8_WAIT_V(8); PG8_WAIT_L(0); PG8_BAR; PG8_MMA(1, 0, At, B0); PG8_MMA(1, 1, At, B1); PG8_BAR; PG8_SCHED;
            } else {
            PG8_LDB(B0, 0, 0); PG8_SCHED; PG8_LDA(At, 0, 0); PG8_STAGE(PG8_SA(1, 1), a1 + hA, voffA);
            PG8_WAIT_L(8); PG8_BAR; PG8_WAIT_L(0); PG8_MMA(0, 0, At, B0); PG8_BAR; PG8_SCHED;
            PG8_LDB(B1, 0, 1); PG8_STAGE(PG8_SB(0, 0), b2, voffB);
            PG8_BAR; PG8_WAIT_L(0); PG8_MMA(0, 1, At, B1); PG8_BAR;
            PG8_LDA(At, 0, 1); PG8_STAGE(PG8_SA(0, 0), a2, voffA);
            PG8_BAR; PG8_WAIT_L(0); PG8_MMA(1, 0, At, B0); PG8_BAR; PG8_SCHED;
            PG8_STAGE(PG8_SB(0, 1), b2 + hB, voffB);
            PG8_WAIT_V(6); PG8_BAR; PG8_MMA(1, 1, At, B1); PG8_BAR;
            PG8_LDB(B0, 1, 0); PG8_SCHED; PG8_LDA(At, 1, 0); PG8_STAGE(PG8_SA(0, 1), a2 + hA, voffA);
            PG8_WAIT_L(8); PG8_BAR; PG8_WAIT_L(0); PG8_MMA(0, 0, At, B0); PG8_BAR; PG8_SCHED;
            PG8_LDB(B1, 1, 1); PG8_STAGE(PG8_SB(1, 0), b3, voffB);
            PG8_BAR; PG8_WAIT_L(0); PG8_MMA(0, 1, At, B1); PG8_BAR;
            PG8_LDA(At, 1, 1); PG8_STAGE(PG8_SA(1, 0), a3, voffA);
            PG8_BAR; PG8_WAIT_L(0); PG8_MMA(1, 0, At, B0); PG8_BAR; PG8_SCHED;
            PG8_STAGE(PG8_SB(1, 1), b3 + hB, voffB);
            PG8_WAIT_V(6); PG8_BAR; PG8_MMA(1, 1, At, B1); PG8_BAR;
            }
        }
        if constexpr (ALIGN_EPI) { if (wr == 0) PG8_BAR; }
        if constexpr (!Epi::AFTER_DRAIN) { const int l2_ = opaque_tid(0) & 63; E(acc, cur, wr, wc, l2_ & 15, l2_ >> 4); S.done(cur); }
        if (!has_next) break;
#pragma unroll
        for (int a = 0; a < 2; ++a)
#pragma unroll
            for (int b = 0; b < 2; ++b)
#pragma unroll
                for (int m = 0; m < 4; ++m)
#pragma unroll
                    for (int n = 0; n < 2; ++n) acc[a][b][m][n] = (f32x4){0.f, 0.f, 0.f, 0.f};
        cur = nxt; cA = nA; cB = nB; ++ui;
        if constexpr (ALIGN_EPI) { if (wr == 1) PG8_BAR; }
    }
    PG8_WAIT_V(0);
    if constexpr (!ALIGN_EPI) { if (wr == 0) PG8_BAR; }
    PG8_BAR;
    if constexpr (Epi::AFTER_DRAIN) { E.fused(acc, cur, wr, wc, fr, fq, lds, wid, lane); S.done(cur); }
#undef PG8_SA
#undef PG8_SB
#undef PG8_STAGE
#undef PG8_LDA
#undef PG8_LDB
#undef PG8_MMA
#undef PG8_WAIT_V
#undef PG8_WAIT_L
#undef PG8_BAR
#undef PG8_SCHED
}
}

__device__ __forceinline__ void conv_slab(const Ctx& c, int pm, int pn, const bf16_t* proj, const float* cw, const float* cb, bf16_t* uc) {
    const int ch0 = 256 * pn + 8 * (c.tid & 31);
    float wv[4][8], bv[8];
#pragma unroll
    for (int jt = 0; jt < 4; ++jt) { const f32x4 a = *(const f32x4*)(cw + jt * 512 + ch0), b = *(const f32x4*)(cw + jt * 512 + ch0 + 4);
#pragma unroll
        for (int e = 0; e < 4; ++e) { wv[jt][e] = a[e]; wv[jt][4 + e] = b[e]; } }
    { const f32x4 a = *(const f32x4*)(cb + ch0), b = *(const f32x4*)(cb + ch0 + 4);
#pragma unroll
      for (int e = 0; e < 4; ++e) { bv[e] = a[e]; bv[4 + e] = b[e]; } }
    u32x4 raw[4][7];
#pragma unroll
    for (int i = 0; i < 4; ++i) { const int it = c.tid + NTHREADS * i, t0 = 256 * pm + 4 * (it >> 5), s0 = t0 & (SEQ - 1);
#pragma unroll
        for (int r = 0; r < 7; ++r) { u32x4 v = {0u, 0u, 0u, 0u}; if (s0 + r - 3 >= 0) v = *(const u32x4*)(proj + (size_t)(t0 + r - 3) * NPROJ + PC_U + ch0); raw[i][r] = v; } }
#pragma unroll
    for (int i = 0; i < 4; ++i) { const int it = c.tid + NTHREADS * i, t0 = 256 * pm + 4 * (it >> 5);
        float xr[7][8];
#pragma unroll
        for (int r = 0; r < 7; ++r)
#pragma unroll
            for (int e = 0; e < 4; ++e) { xr[r][2 * e] = bflo(raw[i][r][e]); xr[r][2 * e + 1] = bfhi(raw[i][r][e]); }
#pragma unroll
        for (int q = 0; q < 4; ++q) { u32x4 o;
#pragma unroll
            for (int e = 0; e < 4; ++e) { float a0 = bv[2 * e], a1 = bv[2 * e + 1];
#pragma unroll
                for (int jt = 0; jt < 4; ++jt) { a0 += wv[jt][2 * e] * xr[q + jt][2 * e]; a1 += wv[jt][2 * e + 1] * xr[q + jt][2 * e + 1]; }
                o[e] = pk2(a0 * sigmoidf_(a0), a1 * sigmoidf_(a1)); }
            *(u32x4*)(uc + (size_t)(t0 + q) * 512 + ch0) = o; }
    }
}
__device__ __forceinline__ void kr_prep(const Ctx& c, const bf16_t* proj, const float* gk, const float* cosb, const float* sinb, const float* st_kr, bf16_t* kr) {
    const size_t gt = (size_t)(c.wg / c.ng) * NTHREADS + c.tid, GT = (size_t)(c.nwg / c.ng) * NTHREADS, tg8 = (size_t)(T / c.ng) * 8;
    for (size_t ib = gt; ib < tg8; ib += 2 * GT) {
        u32x2 a[2], b[2]; float s0[2], s1[2]; f32x4 cs[2], sn[2]; size_t tt[2]; bool ok[2];
        const int i0 = (int)(ib & 7) * 4;
        const f32x4 ga = *(const f32x4*)(gk + 128 + i0), gb = *(const f32x4*)(gk + 160 + i0);
#pragma unroll
        for (int u = 0; u < 2; ++u) { const size_t i = ib + u * GT; ok[u] = i < tg8; const size_t t = (size_t)c.g * (T / c.ng) + ((ok[u] ? i : ib) >> 3); tt[u] = t; const bf16_t* pr = proj + t * NPROJ + PC_KR;
            a[u] = *(const u32x2*)(pr + i0); b[u] = *(const u32x2*)(pr + 32 + i0); s0[u] = st_kr[t * 2]; s1[u] = st_kr[t * 2 + 1]; cs[u] = *(const f32x4*)(cosb + t * 32 + i0); sn[u] = *(const f32x4*)(sinb + t * 32 + i0); }
#pragma unroll
        for (int u = 0; u < 2; ++u) if (ok[u]) { const size_t t = tt[u]; const float rs = rsqrtf((s0[u] + s1[u]) * (1.0f / 64.0f) + EPS);
            const float y1[4] = {bflo(a[u].x) * rs * ga[0], bfhi(a[u].x) * rs * ga[1], bflo(a[u].y) * rs * ga[2], bfhi(a[u].y) * rs * ga[3]}, y2[4] = {bflo(b[u].x) * rs * gb[0], bfhi(b[u].x) * rs * gb[1], bflo(b[u].y) * rs * gb[2], bfhi(b[u].y) * rs * gb[3]};
            u32x2 oa, ob; oa.x = pk2(y1[0] * cs[u][0] - y2[0] * sn[u][0], y1[1] * cs[u][1] - y2[1] * sn[u][1]); oa.y = pk2(y1[2] * cs[u][2] - y2[2] * sn[u][2], y1[3] * cs[u][3] - y2[3] * sn[u][3]);
            ob.x = pk2(y2[0] * cs[u][0] + y1[0] * sn[u][0], y2[1] * cs[u][1] + y1[1] * sn[u][1]); ob.y = pk2(y2[2] * cs[u][2] + y1[2] * sn[u][2], y2[3] * cs[u][3] + y1[3] * sn[u][3]);
            *(u32x2*)(kr + t * 64 + i0) = oa; *(u32x2*)(kr + t * 64 + 32 + i0) = ob; } }
}
typedef short bf16x8_t __attribute__((ext_vector_type(8)));
typedef short s16x4_t __attribute__((ext_vector_type(4)));
typedef float f32x16 __attribute__((ext_vector_type(16)));
__device__ __forceinline__ unsigned cvtpk_bf16(float lo, float hi) { unsigned r; asm volatile("v_cvt_pk_bf16_f32 %0, %1, %2\n\ts_nop 1" : "=v"(r) : "v"(lo), "v"(hi));     return r; }
#define TR_READ(dst, base, OFF) asm volatile("ds_read_b64_tr_b16 %0, %1 offset:%2" : "=&v"(dst) : "v"(base), "i"(OFF) : "memory")
#define TR_WAIT() do { asm volatile("s_waitcnt lgkmcnt(0)" ::: "memory"); __builtin_amdgcn_sched_barrier(0); } while (0)
#define TR_PACK(lo_, hh_) ((bf16x8_t){lo_[0], lo_[1], lo_[2], lo_[3], hh_[0], hh_[1], hh_[2], hh_[3]})
__device__ __forceinline__ float xhalf_max(float v) { auto rr = __builtin_amdgcn_permlane32_swap(__float_as_uint(v), __float_as_uint(v), false, false); return fmaxf(__uint_as_float(rr[0]), __uint_as_float(rr[1])); }
__device__ __forceinline__ float xhalf_sum(float v) { auto rr = __builtin_amdgcn_permlane32_swap(__float_as_uint(v), __float_as_uint(v), false, false); return __uint_as_float(rr[0]) + __uint_as_float(rr[1]); }
template <int DQ, bool CAUSAL, bool ONORM>
__device__ __forceinline__ void attn_block(const Ctx& c, int b, int h, int qb, const bf16_t* Q, int ldq, const bf16_t* K1, int ldk1, const bf16_t* K2, const bf16_t* V, int ldv, int SK, bf16_t* O, int ldo, int ocol0, const float* gain,
                                           const float* gq, const float* cosb, const float* sinb, float qscale) {
    constexpr int NI1 = 17, NI2 = DQ == 192 ? 9 : 0, NIV = 20, NINS = NI1 + NI2 + NIV, BUFB = NINS * 1024, K1P = 272, K2P = 144, VP = 320, NKS = DQ / 16, NPW = (NINS + 7) / 8;
    static_assert(2 * BUFB <= LDSCTL_OFF && (DQ == 192 || DQ == 128), "attn_mfma geometry");
    const int lane = c.lane, w = c.wave, q32 = lane & 31, hi = lane >> 5;
    LAS unsigned char* const lds = c.lds;
    const int vrd = (4 * (lane >> 5) + ((lane >> 2) & 3)) * VP + (16 * ((lane >> 4) & 1) + 4 * (lane & 3)) * 2;
    unsigned soff[NPW];
#pragma unroll
    for (int i = 0; i < NPW; ++i) { const int idx = w + 8 * i, ci = idx * 64 + lane;
        if (idx < NI1) { const int key = ci / 17, ch = ci % 17; soff[i] = (unsigned)(key * ldk1 * 2 + (ch < 15 ? ch : 15) * 16); }
        else if (idx < NI1 + NI2) { const int cc = ci - NI1 * 64, key = cc / 9, ch = cc % 9; soff[i] = (unsigned)(key * 128 + (ch < 7 ? ch : 7) * 16); }
        else { const int cc = ci - (NI1 + NI2) * 64, key = cc / 20, ch = cc % 20; soff[i] = (unsigned)(key * ldv * 2 + (ch < 15 ? ch : 15) * 16); } }
    {
        {
            const int NT = CAUSAL ? 4 * qb + 4 : SK / 64;
            const size_t kbase = (size_t)b * SK, qrow = (size_t)b * SEQ + qb * 256 + w * 32 + q32;
            const int qg = qb * 256 + w * 32 + q32;
            bf16x8_t qf[NKS];
#pragma unroll
            for (int ks = 0; ks < NKS; ++ks) qf[ks] = *(const bf16x8_t*)(Q + qrow * ldq + h * DQ + 16 * ks + 8 * hi);
            {
                float ss = 0.f;
#pragma unroll
                for (int ks = 0; ks < 8; ++ks) { const u32x4 wq = __builtin_bit_cast(u32x4, qf[ks]);
#pragma unroll
                    for (int i = 0; i < 4; ++i) ss += bflo(wq[i]) * bflo(wq[i]) + bfhi(wq[i]) * bfhi(wq[i]); }
                const float rs = rsqrtf(xhalf_sum(ss) * (1.0f / 128.0f) + EPS) * qscale;
#pragma unroll
                for (int ks = 0; ks < 8; ++ks) { const u32x4 wq = __builtin_bit_cast(u32x4, qf[ks]); const f32x4 g0 = *(const f32x4*)(gq + 16 * ks + 8 * hi), g1 = *(const f32x4*)(gq + 16 * ks + 8 * hi + 4); u32x4 o4;
                    o4[0] = cvtpk_bf16(bflo(wq[0]) * rs * g0[0], bfhi(wq[0]) * rs * g0[1]); o4[1] = cvtpk_bf16(bflo(wq[1]) * rs * g0[2], bfhi(wq[1]) * rs * g0[3]);
                    o4[2] = cvtpk_bf16(bflo(wq[2]) * rs * g1[0], bfhi(wq[2]) * rs * g1[1]); o4[3] = cvtpk_bf16(bflo(wq[3]) * rs * g1[2], bfhi(wq[3]) * rs * g1[3]);
                    qf[ks] = __builtin_bit_cast(bf16x8_t, o4); }
                if (DQ == 192) {
                    float sr = 0.f;
#pragma unroll
                    for (int ks = 8; ks < NKS; ++ks) { const u32x4 wq = __builtin_bit_cast(u32x4, qf[ks]);
#pragma unroll
                        for (int i = 0; i < 4; ++i) sr += bflo(wq[i]) * bflo(wq[i]) + bfhi(wq[i]) * bfhi(wq[i]); }
                    const float rr = rsqrtf(xhalf_sum(sr) * (1.0f / 64.0f) + EPS);
#pragma unroll
                    for (int kp = 0; kp < 2; ++kp) {
                        const int i0 = 16 * kp + 8 * hi; const u32x4 wa = __builtin_bit_cast(u32x4, qf[8 + kp]), wb = __builtin_bit_cast(u32x4, qf[10 + kp]);
                        float y1[8], y2[8], cs[8], sn[8], ga[8], gb[8];
#pragma unroll
                        for (int q4 = 0; q4 < 2; ++q4) { const f32x4 c4 = *(const f32x4*)(cosb + qrow * 32 + i0 + 4 * q4), s4 = *(const f32x4*)(sinb + qrow * 32 + i0 + 4 * q4), a4 = *(const f32x4*)(gq + 128 + i0 + 4 * q4), b4 = *(const f32x4*)(gq + 160 + i0 + 4 * q4);
#pragma unroll
                            for (int e = 0; e < 4; ++e) { cs[4 * q4 + e] = c4[e]; sn[4 * q4 + e] = s4[e]; ga[4 * q4 + e] = a4[e]; gb[4 * q4 + e] = b4[e]; } }
#pragma unroll
                        for (int i = 0; i < 4; ++i) { y1[2 * i] = bflo(wa[i]) * rr * ga[2 * i]; y1[2 * i + 1] = bfhi(wa[i]) * rr * ga[2 * i + 1]; y2[2 * i] = bflo(wb[i]) * rr * gb[2 * i]; y2[2 * i + 1] = bfhi(wb[i]) * rr * gb[2 * i + 1]; }
                        u32x4 oa, ob;
#pragma unroll
                        for (int i = 0; i < 4; ++i) { oa[i] = cvtpk_bf16((y1[2 * i] * cs[2 * i] - y2[2 * i] * sn[2 * i]) * qscale, (y1[2 * i + 1] * cs[2 * i + 1] - y2[2 * i + 1] * sn[2 * i + 1]) * qscale);
                                                      ob[i] = cvtpk_bf16((y2[2 * i] * cs[2 * i] + y1[2 * i] * sn[2 * i]) * qscale, (y2[2 * i + 1] * cs[2 * i + 1] + y1[2 * i + 1] * sn[2 * i + 1]) * qscale); }
                        qf[8 + kp] = __builtin_bit_cast(bf16x8_t, oa); qf[10 + kp] = __builtin_bit_cast(bf16x8_t, ob); }
                }
            }
            f32x16 o[4];
#pragma unroll
            for (int d = 0; d < 4; ++d)
#pragma unroll
                for (int r = 0; r < 16; ++r) o[d][r] = 0.f;
            float m = -1e30f, l = 0.f;
            const unsigned char* g1 = (const unsigned char*)(K1 + kbase * ldk1 + h * 128);
            const unsigned char* g2 = (const unsigned char*)(K2 + kbase * 64);
            const unsigned char* gv = (const unsigned char*)(V + kbase * ldv + h * 128);
#define ATT_DMA(t_, buf_) do { \
                _Pragma("unroll") for (int i = 0; i < NPW; ++i) { const int idx = w + 8 * i; if (idx < NINS) { \
                    const unsigned char* gp = idx < NI1 ? g1 + (size_t)(t_) * 128 * ldk1 : idx < NI1 + NI2 ? g2 + (size_t)(t_) * 8192 : gv + (size_t)(t_) * 128 * ldv; \
                    __builtin_amdgcn_global_load_lds((const unsigned*)(gp + soff[i]), (LAS unsigned*)(lds + (buf_) * BUFB + idx * 1024), 16, 0, 0); } } } while (0)
            ATT_DMA(0, 0);
            asm volatile("s_waitcnt vmcnt(0)" ::: "memory");
            __syncthreads();
            for (int t = 0; t < NT; ++t) {
                const int buf = t & 1;
                if (t + 1 < NT) ATT_DMA(t + 1, buf ^ 1);
                if (!CAUSAL || 64 * t <= qb * 256 + w * 32 + 31) {
                    const LAS unsigned char* Kb = lds + buf * BUFB + q32 * K1P + hi * 16;
                    const LAS unsigned char* Kb2 = lds + buf * BUFB + NI1 * 1024 + q32 * K2P + hi * 16;
                    f32x16 p0, p1;
#pragma unroll
                    for (int r = 0; r < 16; ++r) { p0[r] = 0.f; p1[r] = 0.f; }
                    {
                        const unsigned kba = (unsigned)(size_t)Kb, kba2 = (unsigned)(size_t)Kb2;
                        bf16x8_t ka0, ka1, kb0, kb1;
#define ATT_KR(dst, base, OFF) asm volatile("ds_read_b128 %0, %1 offset:%2" : "=&v"(dst) : "v"(base), "i"(OFF) : "memory")
#define ATT_KRD(ks_, D0, D1) do { if ((ks_) < 8) { ATT_KR(D0, kba, ((ks_) & 7) * 32); ATT_KR(D1, kba, 32 * K1P + ((ks_) & 7) * 32); } else { ATT_KR(D0, kba2, ((ks_) & 7) * 32); ATT_KR(D1, kba2, 32 * K2P + ((ks_) & 7) * 32); } } while (0)
#define ATT_KSTEP(ks_, C0, C1, N0, N1) do { if ((ks_) + 1 < NKS) { ATT_KRD((ks_) + 1, N0, N1); asm volatile("s_waitcnt lgkmcnt(2)" ::: "memory"); } else asm volatile("s_waitcnt lgkmcnt(0)" ::: "memory"); \
                            __builtin_amdgcn_sched_barrier(0); \
                            p0 = __builtin_amdgcn_mfma_f32_32x32x16_bf16(C0, qf[ks_], p0, 0, 0, 0); p1 = __builtin_amdgcn_mfma_f32_32x32x16_bf16(C1, qf[ks_], p1, 0, 0, 0); \
                            __builtin_amdgcn_sched_barrier(0); } while (0)
                        ATT_KRD(0, ka0, ka1);
                        ATT_KSTEP(0, ka0, ka1, kb0, kb1); ATT_KSTEP(1, kb0, kb1, ka0, ka1); ATT_KSTEP(2, ka0, ka1, kb0, kb1); ATT_KSTEP(3, kb0, kb1, ka0, ka1);
                        ATT_KSTEP(4, ka0, ka1, kb0, kb1); ATT_KSTEP(5, kb0, kb1, ka0, ka1); ATT_KSTEP(6, ka0, ka1, kb0, kb1); ATT_KSTEP(7, kb0, kb1, ka0, ka1);
                        if (NKS > 8) { ATT_KSTEP(8, ka0, ka1, kb0, kb1); ATT_KSTEP(9, kb0, kb1, ka0, ka1); ATT_KSTEP(10, ka0, ka1, kb0, kb1); ATT_KSTEP(11, kb0, kb1, ka0, ka1); }
#undef ATT_KR
#undef ATT_KRD
#undef ATT_KSTEP
                    }
                    if (CAUSAL && t >= 4 * qb) {
                        const int d0 = qg - 64 * t - 4 * hi;
#pragma unroll
                        for (int r = 0; r < 16; ++r) { const int cr = (r & 3) + 8 * (r >> 2); if (cr > d0) p0[r] = -INFINITY; if (cr + 32 > d0) p1[r] = -INFINITY; }
                    }
                    const unsigned vba = (unsigned)(size_t)(lds + buf * BUFB + (NI1 + NI2) * 1024 + vrd);
#define ATT_PVR(S, L0, H0, L1, H1, L2, H2, L3, H3) do { \
                        TR_READ(L0, vba, (16 * (S)) * VP + 0); TR_READ(H0, vba, (16 * (S) + 8) * VP + 0); TR_READ(L1, vba, (16 * (S)) * VP + 64); TR_READ(H1, vba, (16 * (S) + 8) * VP + 64); \
                        TR_READ(L2, vba, (16 * (S)) * VP + 128); TR_READ(H2, vba, (16 * (S) + 8) * VP + 128); TR_READ(L3, vba, (16 * (S)) * VP + 192); TR_READ(H3, vba, (16 * (S) + 8) * VP + 192); } while (0)
#define ATT_PVC(S, PF) do { u32x4 pw_; \
                        _Pragma("unroll") for (int j_ = 0; j_ < 4; ++j_) pw_[j_] = (S) < 2 ? cvtpk_bf16(p0[8 * (S) + 2 * j_], p0[8 * (S) + 2 * j_ + 1]) : cvtpk_bf16(p1[8 * ((S) - 2) + 2 * j_], p1[8 * ((S) - 2) + 2 * j_ + 1]); \
                        PF = __builtin_bit_cast(bf16x8_t, pw_); } while (0)
#define ATT_PVM(PF, L0, H0, L1, H1, L2, H2, L3, H3) do { \
                        o[0] = __builtin_amdgcn_mfma_f32_32x32x16_bf16(TR_PACK(L0, H0), PF, o[0], 0, 0, 0); o[1] = __builtin_amdgcn_mfma_f32_32x32x16_bf16(TR_PACK(L1, H1), PF, o[1], 0, 0, 0); \
                        o[2] = __builtin_amdgcn_mfma_f32_32x32x16_bf16(TR_PACK(L2, H2), PF, o[2], 0, 0, 0); o[3] = __builtin_amdgcn_mfma_f32_32x32x16_bf16(TR_PACK(L3, H3), PF, o[3], 0, 0, 0); } while (0)
#define TR_WAITN(n) do { asm volatile("s_waitcnt lgkmcnt(" #n ")" ::: "memory"); __builtin_amdgcn_sched_barrier(0); } while (0)
                    bf16x8_t pfa, pfb; s16x4_t la0, ha0, la1, ha1, la2, ha2, la3, ha3, lb0, hb0, lb1, hb1, lb2, hb2, lb3, hb3;
                    ATT_PVR(0, la0, ha0, la1, ha1, la2, ha2, la3, ha3);
                    ATT_PVR(1, lb0, hb0, lb1, hb1, lb2, hb2, lb3, hb3);
                    __builtin_amdgcn_s_setprio(1);
                    float mx = fmaxf(p0[0], p1[0]);
#pragma unroll
                    for (int r = 1; r < 16; ++r) mx = fmaxf(mx, fmaxf(p0[r], p1[r]));
                    mx = xhalf_max(mx);
                    float mn = m, alpha = 1.0f;
                    if (!__all(mx - m <= 8.0f)) { mn = fmaxf(m, mx); alpha = __builtin_amdgcn_exp2f(m - mn); m = mn; }
                    float ps = 0.f;
#pragma unroll
                    for (int r = 0; r < 16; ++r) { p0[r] = __builtin_amdgcn_exp2f(p0[r] - mn); p1[r] = __builtin_amdgcn_exp2f(p1[r] - mn); ps += p0[r] + p1[r]; }
                    l = l * alpha + ps;
                    if (!__all(alpha == 1.0f)) {
#pragma unroll
                        for (int d = 0; d < 4; ++d)
#pragma unroll
                            for (int r = 0; r < 16; ++r) o[d][r] *= alpha;
                    }
                    ATT_PVC(0, pfa); ATT_PVC(1, pfb);
                    TR_WAITN(8); ATT_PVM(pfa, la0, ha0, la1, ha1, la2, ha2, la3, ha3);
                    ATT_PVR(2, la0, ha0, la1, ha1, la2, ha2, la3, ha3); ATT_PVC(2, pfa);
                    TR_WAITN(8); ATT_PVM(pfb, lb0, hb0, lb1, hb1, lb2, hb2, lb3, hb3);
                    ATT_PVR(3, lb0, hb0, lb1, hb1, lb2, hb2, lb3, hb3); ATT_PVC(3, pfb);
                    TR_WAITN(8); ATT_PVM(pfa, la0, ha0, la1, ha1, la2, ha2, la3, ha3);
                    TR_WAITN(0); ATT_PVM(pfb, lb0, hb0, lb1, hb1, lb2, hb2, lb3, hb3);
                    __builtin_amdgcn_s_setprio(0);
#undef ATT_PVR
#undef ATT_PVC
#undef ATT_PVM
#undef TR_WAITN
                }
                asm volatile("s_waitcnt vmcnt(0)" ::: "memory");
                __syncthreads();
            }
#undef ATT_DMA
            const float inv = __builtin_amdgcn_rcpf(xhalf_sum(l));
            float ss = 0.f;
#pragma unroll
            for (int d = 0; d < 4; ++d)
#pragma unroll
                for (int r = 0; r < 16; ++r) { o[d][r] *= inv; ss += o[d][r] * o[d][r]; }
            float rs = 1.0f;
            if (ONORM) rs = rsqrtf(xhalf_sum(ss) * (1.0f / 128.0f) + EPS);
            LAS unsigned char* stg = lds + w * (32 * 272);
#pragma unroll
            for (int d = 0; d < 4; ++d)
#pragma unroll
                for (int r4 = 0; r4 < 4; ++r4) { const int dv = 32 * d + 8 * r4;
                    f32x4 v = {o[d][4 * r4], o[d][4 * r4 + 1], o[d][4 * r4 + 2], o[d][4 * r4 + 3]};
                    if (ONORM) v = v * rs * *(const f32x4*)(gain + h * 128 + dv + 4 * hi);
                    u32x2 wv; wv.x = cvtpk_bf16(v[0], v[1]); wv.y = cvtpk_bf16(v[2], v[3]); *(LAS u32x2*)(stg + q32 * 272 + (dv + 4 * hi) * 2) = wv; }
            asm volatile("s_waitcnt lgkmcnt(0)" ::: "memory");
            bf16_t* ob = O + ((size_t)b * SEQ + qb * 256 + w * 32) * ldo + ocol0 + h * 128;
#pragma unroll
            for (int i2 = 0; i2 < 8; ++i2) { const int pcs = lane + 64 * i2, row = pcs >> 4, pc = pcs & 15; *(u32x4*)(ob + (size_t)row * ldo + pc * 8) = *(const LAS u32x4*)(stg + row * 272 + pc * 16); }
            __syncthreads();
        }
    }
}


template <int DQ, bool CAUSAL, bool ONORM>
__device__ __forceinline__ void attn_mfma(const Ctx& c, const bf16_t* Q, int ldq, const bf16_t* K1, int ldk1, const bf16_t* K2, const bf16_t* V, int ldv, int SK, bf16_t* O, int ldo, int ocol0, const float* gain, const float* gq, const float* cosb, const float* sinb, float qscale) {
    const int vcu = (c.nwg % 8 == 0) ? (c.wg % 8) * (c.nwg / 8) + c.wg / 8 : c.wg;
    for (int item = vcu; item < BATCH * 4 * 8; item += c.nwg) attn_block<DQ, CAUSAL, ONORM>(c, item >> 5, (item >> 3) & 3, item & 7, Q, ldq, K1, ldk1, K2, V, ldv, SK, O, ldo, ocol0, gain, gq, cosb, sinb, qscale);
}
__device__ __forceinline__ float lane_get(float v, int src) { return __int_as_float(__builtin_amdgcn_ds_bpermute(src << 2, __float_as_int(v))); }
__device__ __forceinline__ bf16x8_t scale8(bf16x8_t f, float s) { const u32x4 w = __builtin_bit_cast(u32x4, f); u32x4 o;
#pragma unroll
    for (int i = 0; i < 4; ++i) o[i] = cvtpk_bf16(bflo(w[i]) * s, bfhi(w[i]) * s);
    return __builtin_bit_cast(bf16x8_t, o); }
__device__ __forceinline__ void mlstm_unit(const Ctx& c, int unit, bf16_t* qkm, const bf16_t* proj, const float* gates, const float* mg, bf16_t* ymix) {
    constexpr int QP = 144, VP = 320, NINS = 38, BUFB = NINS * 1024, KOFF = 9 * 1024, VOFF = 18 * 1024, COFF = 2 * BUFB, NOFF = COFF + 64 * VP, SSOFF = NOFF + 256, NPOFF = SSOFF + 1024, EGOFF = NPOFF + 2048,
                  SJOFF = EGOFF + 8192, EOFF = SJOFF + 8192, BTOFF = EOFF + 8192, P63OFF = BTOFF + 128, SOOFF = P63OFF + 128, CCOFF = SOOFF + 128, OTOFF = CCOFF + 128, OP = 272, YTOFF = OTOFF + 64 * OP, EUOFF = YTOFF  ,
                  LEND = YTOFF + 64 * OP, NPW = 5, NCHUNK = SEQ / 64;
    static_assert(LEND <= LDSCTL_OFF, "mlstm LDS map");
    const int lane = c.lane, w = c.wave, c32 = lane & 31, hi = lane >> 5, x = w >> 2, dvb = w & 3, tid = c.tid;
    LAS unsigned char* const lds = c.lds;
    unsigned soff[NPW];
#pragma unroll
    for (int i = 0; i < NPW; ++i) { const int idx = w + 8 * i, ci = idx * 64 + lane;
        if (idx < 9) { const int key = ci / 9, ch = ci % 9; soff[i] = (unsigned)(key * 1024 + (ch < 7 ? ch : 7) * 16); }
        else if (idx < 18) { const int cc = ci - 576, key = cc / 9, ch = cc % 9; soff[i] = (unsigned)(key * 1024 + 128 + (ch < 7 ? ch : 7) * 16); }
        else { const int cc = ci - 1152, key = cc / 20, ch = cc % 20; soff[i] = (unsigned)(key * 4096 + (ch < 15 ? ch : 15) * 16); } }
    unsigned ooff[3];
#pragma unroll
    for (int i = 0; i < 3; ++i) { const int ci = (w + 8 * i) * 64 + lane, key = ci / 17, chn = ci % 17; ooff[i] = (unsigned)(key * 4096 + (chn < 15 ? chn : 15) * 16); }
    const int colb = (16 * ((lane >> 4) & 1) + 4 * (lane & 3)) * 2, rq = (lane >> 2) & 3;
    const int vrd = (4 * hi + rq) * VP + colb + 64 * dvb;
    const int crd = (8 * hi + rq) * VP + colb + 64 * dvb;
    const int krd = (4 * hi + rq) * QP + colb + 64 * x;
    const int j = 32 * x + c32;
    const int b = unit >> 2, h = unit & 3; const size_t t0 = (size_t)b * SEQ;
    const unsigned char* gq = (const unsigned char*)(qkm + t0 * 512 + h * 128);
    const unsigned char* gv = (const unsigned char*)(proj + t0 * NPROJ + PC_V + h * 128);
#define ML_DMA(ch_, buf_) do { \
        _Pragma("unroll") for (int i = 0; i < NPW; ++i) { const int idx = w + 8 * i; if (idx < NINS) { \
            const unsigned char* gp = idx < 18 ? gq + (size_t)(ch_) * 65536 : gv + (size_t)(ch_) * 262144; \
            __builtin_amdgcn_global_load_lds((const unsigned*)(gp + soff[i]), (LAS unsigned*)(lds + (buf_) * BUFB + idx * 1024), 16, 0, 16  ); } } } while (0)
    const unsigned char* go = (const unsigned char*)(proj + t0 * NPROJ + PC_O + h * 128);
#define ML_DMA_O(ch_) do { _Pragma("unroll") for (int i = 0; i < 3; ++i) { const int idx = w + 8 * i; if (idx < 17) \
            __builtin_amdgcn_global_load_lds((const unsigned*)(go + (size_t)(ch_) * 262144 + ooff[i]), (LAS unsigned*)(lds + OTOFF + idx * 1024), 16, 0, 0); } } while (0)
#define ML_YSTORE(ch_) do { _Pragma("unroll") for (int i = 0; i < 2; ++i) { const int p_ = tid + NTHREADS * i, row_ = p_ >> 4, pc_ = p_ & 15; \
            *(u32x4*)(ymix + (t0 + (size_t)(ch_) * 64 + row_) * D + h * 128 + pc_ * 8) = *(const LAS u32x4*)(lds + YTOFF + row_ * OP + pc_ * 16); } } while (0)
    for (int i = tid; i < (64 * VP + 256) / 4; i += NTHREADS) ((LAS unsigned*)(lds + COFF))[i] = 0u;
    float bsq[4], pmq[4], uq[4];
    {   float igq[4], fgq[4];
#pragma unroll
        for (int q = 0; q < 4; ++q) { const size_t t = t0 + (size_t)(4 * w + q) * 64 + lane; igq[q] = gates[t * 8 + h]; fgq[q] = gates[t * 8 + 4 + h]; }
#pragma unroll
        for (int q = 0; q < 4; ++q) { const float fg = fgq[q]; float bs = fminf(fg, 0.f) - log1pf(__expf(-fabsf(fg)));
#pragma unroll
            for (int o = 1; o < 64; o <<= 1) { const float t = lane_get(bs, lane - o); if (lane >= o) bs += t; }
            const float u = igq[q] - bs; float pm = u;
#pragma unroll
            for (int o = 1; o < 64; o <<= 1) { const float t = lane_get(pm, lane - o); if (lane >= o) pm = fmaxf(pm, t); }
            bsq[q] = bs; pmq[q] = pm; uq[q] = u;
            if (lane == 63) { *(LAS float*)(lds + BTOFF + (4 * w + q) * 4) = bs; *(LAS float*)(lds + P63OFF + (4 * w + q) * 4) = pm; } }
    }
    __syncthreads();
    float mpq[4];
    {   float m = 0.f;
        for (int cc = 0; cc < NCHUNK; ++cc) { const float bt = *(const LAS float*)(lds + BTOFF + cc * 4), p63 = *(const LAS float*)(lds + P63OFF + cc * 4), mn = fmaxf(bt + m, bt + p63);
            if (w == 0 && lane == 0) { *(LAS float*)(lds + SOOFF + cc * 4) = __expf(bt + m - mn); *(LAS float*)(lds + CCOFF + cc * 4) = __expf(p63 + bt - mn); }
#pragma unroll
            for (int q = 0; q < 4; ++q) if (cc == 4 * w + q) mpq[q] = m;
            m = mn; }
    }
#pragma unroll
    for (int q = 0; q < 4; ++q) { const int p = ((4 * w + q) * 64 + lane) * 4; const float g = fmaxf(mpq[q], pmq[q]), p63 = lane_get(pmq[q], 63);
        *(LAS float*)(lds + EGOFF + p) = __builtin_amdgcn_exp2f(fminf((p63 - g) * LOG2E - 3.0f, 120.0f)); *(LAS float*)(lds + SJOFF + p) = __expf(mpq[q] - g) * 0.125f;
        *(LAS float*)(lds + EOFF + p) = __expf(-(bsq[q] + g)); *(LAS float*)(lds + EUOFF + p) = __expf(uq[q] - p63); }
    __syncthreads();
    {   bf16_t* kb = qkm + t0 * 512 + h * 128 + 64;
#pragma unroll 4
        for (int i = 0; i < 32; ++i) { const int idx = tid + NTHREADS * i, row = idx >> 3, pc = idx & 7; u32x4* p = (u32x4*)(kb + (size_t)row * 512 + pc * 8); const u32x4 v = *p; const float e = *(const LAS float*)(lds + EUOFF + row * 4); u32x4 o;
#pragma unroll
            for (int k4 = 0; k4 < 4; ++k4) o[k4] = cvtpk_bf16(bflo(v[k4]) * e, bfhi(v[k4]) * e);
            *p = o; }
    }
    asm volatile("s_waitcnt vmcnt(0)" ::: "memory");
    __syncthreads();
    ML_DMA(0, 0);
    f32x16 Cacc;
#pragma unroll
    for (int r = 0; r < 16; ++r) Cacc[r] = 0.f;
    for (int ch = 0; ch < NCHUNK; ++ch) {
        const int buf = ch & 1;
        if (ch == 0) asm volatile("s_waitcnt vmcnt(0)" ::: "memory");
        __syncthreads();
        if (ch > 0) ML_YSTORE(ch - 1);
        if (ch + 1 < NCHUNK) ML_DMA(ch + 1, buf ^ 1);
        ML_DMA_O(ch);
        const float sold = *(const LAS float*)(lds + SOOFF + ch * 4), cch = *(const LAS float*)(lds + CCOFF + ch * 4);
        const float egj = *(const LAS float*)(lds + EGOFF + (ch * 64 + j) * 4), sj = *(const LAS float*)(lds + SJOFF + (ch * 64 + j) * 4), ej = *(const LAS float*)(lds + EOFF + (ch * 64 + j) * 4);
        const LAS unsigned char* Qb = lds + buf * BUFB + j * QP + hi * 16;
        const LAS unsigned char* Kb = lds + buf * BUFB + KOFF + c32 * QP + hi * 16;
        const LAS unsigned char* Vb = lds + buf * BUFB + VOFF + vrd;
        const LAS unsigned char* Cb = lds + COFF + crd;
        const LAS unsigned char* Kt = lds + buf * BUFB + KOFF + krd;
        bf16x8_t qf[4], kf0[4], kf1[4], vf[4], cf[4], kt[4];

#pragma unroll
        for (int ks = 0; ks < 4; ++ks) { qf[ks] = *(const LAS bf16x8_t*)(Qb + ks * 32); kf0[ks] = *(const LAS bf16x8_t*)(Kb + ks * 32); kf1[ks] = *(const LAS bf16x8_t*)(Kb + 32 * QP + ks * 32); }
        const unsigned cba = (unsigned)(size_t)Cb, vba = (unsigned)(size_t)Vb, kta = (unsigned)(size_t)Kt;
        s16x4_t cl0, cl1, cl2, cl3, ch0, ch1, ch2, ch3;
        TR_READ(cl0, cba, 0 * VP); TR_READ(ch0, cba, 4 * VP); TR_READ(cl1, cba, 16 * VP); TR_READ(ch1, cba, 20 * VP); TR_READ(cl2, cba, 32 * VP); TR_READ(ch2, cba, 36 * VP); TR_READ(cl3, cba, 48 * VP); TR_READ(ch3, cba, 52 * VP);
        float nsp = 0.f;
        { const LAS unsigned short* kc = (const LAS unsigned short*)(lds + buf * BUFB + KOFF + (8 * w) * QP) + lane;
#pragma unroll
          for (int r = 0; r < 8; ++r) nsp += bf2f(kc[r * (QP / 2)]); }
        TR_WAIT();
        cf[0] = TR_PACK(cl0, ch0); cf[1] = TR_PACK(cl1, ch1); cf[2] = TR_PACK(cl2, ch2); cf[3] = TR_PACK(cl3, ch3);
        f32x16 pS[2], Hint;
#pragma unroll
        for (int r = 0; r < 16; ++r) { pS[0][r] = 0.f; pS[1][r] = 0.f; Hint[r] = 0.f; }
#pragma unroll
        for (int ks = 0; ks < 4; ++ks) {
            pS[0] = __builtin_amdgcn_mfma_f32_32x32x16_bf16(kf0[ks], qf[ks], pS[0], 0, 0, 0);
            pS[1] = __builtin_amdgcn_mfma_f32_32x32x16_bf16(kf1[ks], qf[ks], pS[1], 0, 0, 0);
            Hint = __builtin_amdgcn_mfma_f32_32x32x16_bf16(cf[ks], qf[ks], Hint, 0, 0, 0);
        }
        __builtin_amdgcn_sched_barrier(0);
        s16x4_t vl0, vl1, vl2, vl3, vh0, vh1, vh2, vh3;
        TR_READ(vl0, vba, 0 * VP); TR_READ(vh0, vba, 8 * VP); TR_READ(vl1, vba, 16 * VP); TR_READ(vh1, vba, 24 * VP); TR_READ(vl2, vba, 32 * VP); TR_READ(vh2, vba, 40 * VP); TR_READ(vl3, vba, 48 * VP); TR_READ(vh3, vba, 56 * VP);
        *(LAS float*)(lds + NPOFF + (w * 64 + lane) * 4) = nsp;
        float qn = 0.f;
#pragma unroll
        for (int ks = 0; ks < 4; ++ks) { const u32x4 qw = __builtin_bit_cast(u32x4, qf[ks]); const f32x4 n0 = *(const LAS f32x4*)(lds + NOFF + (16 * ks + 8 * hi) * 4), n1 = *(const LAS f32x4*)(lds + NOFF + (16 * ks + 8 * hi + 4) * 4);
            qn += (bflo(qw[0]) * n0[0] + bfhi(qw[0]) * n0[1]) + (bflo(qw[1]) * n0[2] + bfhi(qw[1]) * n0[3]) + (bflo(qw[2]) * n1[0] + bfhi(qw[2]) * n1[1]) + (bflo(qw[3]) * n1[2] + bfhi(qw[3]) * n1[3]); }
        s16x4_t kl0, kl1, kl2, kl3, kh0, kh1, kh2, kh3;
        TR_READ(kl0, kta, 0 * QP); TR_READ(kh0, kta, 8 * QP); TR_READ(kl1, kta, 16 * QP); TR_READ(kh1, kta, 24 * QP); TR_READ(kl2, kta, 32 * QP); TR_READ(kh2, kta, 40 * QP); TR_READ(kl3, kta, 48 * QP); TR_READ(kh3, kta, 56 * QP);
        TR_WAIT();
        vf[0] = TR_PACK(vl0, vh0); vf[1] = TR_PACK(vl1, vh1); vf[2] = TR_PACK(vl2, vh2); vf[3] = TR_PACK(vl3, vh3);
        kt[0] = TR_PACK(kl0, kh0); kt[1] = TR_PACK(kl1, kh1); kt[2] = TR_PACK(kl2, kh2); kt[3] = TR_PACK(kl3, kh3);
        float psum = 0.f;
#pragma unroll
        for (int r = 0; r < 16; ++r) { const int sl = (r & 3) + 8 * (r >> 2) + 4 * hi; const bool up = sl > c32;
            pS[0][r] = (x == 0 && up) ? 0.f : pS[0][r]; pS[1][r] = (x == 0 || up) ? 0.f : pS[1][r]; psum += pS[0][r] + pS[1][r]; }
        f32x16 Hacc;
#pragma unroll
        for (int r = 0; r < 16; ++r) Hacc[r] = 0.f;
#pragma unroll
        for (int ks = 0; ks < 4; ++ks) { u32x4 pw;
#pragma unroll
            for (int i = 0; i < 4; ++i) pw[i] = cvtpk_bf16(pS[ks >> 1][8 * (ks & 1) + 2 * i], pS[ks >> 1][8 * (ks & 1) + 2 * i + 1]);
            Hacc = __builtin_amdgcn_mfma_f32_32x32x16_bf16(vf[ks], __builtin_bit_cast(bf16x8_t, pw), Hacc, 0, 0, 0); }
        f32x16 Ct;
#pragma unroll
        for (int r = 0; r < 16; ++r) Ct[r] = 0.f;
#pragma unroll
        for (int ks = 0; ks < 4; ++ks) Ct = __builtin_amdgcn_mfma_f32_32x32x16_bf16(vf[ks], kt[ks], Ct, 0, 0, 0);
        f32x4 mgl[4];
#pragma unroll
        for (int r4 = 0; r4 < 4; ++r4) mgl[r4] = *(const f32x4*)(mg + h * 128 + 32 * dvb + 8 * r4 + 4 * hi);
#pragma unroll
        for (int r = 0; r < 16; ++r) Cacc[r] = Cacc[r] * sold + Ct[r] * cch;
        const float den = xhalf_sum(sj * qn + egj * psum), rden = __builtin_amdgcn_rcpf(fmaxf(fabsf(den), ej)), ea = egj * rden, sa = sj * rden;
        float ssp = 0.f;
#pragma unroll
        for (int r = 0; r < 16; ++r) { Hacc[r] = Hacc[r] * ea + Hint[r] * sa; ssp += Hacc[r] * Hacc[r]; }
        ssp = xhalf_sum(ssp);
        if (hi == 0) *(LAS float*)(lds + SSOFF + (dvb * 64 + j) * 4) = ssp;
        const float nold = *(const LAS float*)(lds + NOFF + j * 4);
        asm volatile("s_waitcnt vmcnt(0)" ::: "memory");
        __syncthreads();
        LAS unsigned char* Cw = lds + COFF + j * VP + (32 * dvb + 4 * hi) * 2;
#pragma unroll
        for (int r4 = 0; r4 < 4; ++r4) { u32x2 wv; wv.x = cvtpk_bf16(Cacc[4 * r4], Cacc[4 * r4 + 1]); wv.y = cvtpk_bf16(Cacc[4 * r4 + 2], Cacc[4 * r4 + 3]); *(LAS u32x2*)(Cw + 16 * r4) = wv; }
        if (dvb == 0 && hi == 0) { float ns = 0.f;
#pragma unroll
            for (int r = 0; r < 8; ++r) ns += *(const LAS float*)(lds + NPOFF + (r * 64 + j) * 4);
            *(LAS float*)(lds + NOFF + j * 4) = sold * nold + cch * ns; }
        const float tot = (*(const LAS float*)(lds + SSOFF + j * 4) + *(const LAS float*)(lds + SSOFF + (64 + j) * 4)) + (*(const LAS float*)(lds + SSOFF + (128 + j) * 4) + *(const LAS float*)(lds + SSOFF + (192 + j) * 4));
        const float rs = rsqrtf(tot * (1.0f / 128.0f) + EPS);
        const LAS unsigned char* ot = lds + OTOFF + j * OP + (32 * dvb + 4 * hi) * 2; LAS unsigned char* yt = lds + YTOFF + j * OP + (32 * dvb + 4 * hi) * 2;
#pragma unroll
        for (int r4 = 0; r4 < 4; ++r4) { const f32x4 g4 = mgl[r4] * rs; const u32x2 og = *(const LAS u32x2*)(ot + 16 * r4);
            u32x2 wv; wv.x = cvtpk_bf16(Hacc[4 * r4] * g4[0] * bflo(og.x), Hacc[4 * r4 + 1] * g4[1] * bfhi(og.x)); wv.y = cvtpk_bf16(Hacc[4 * r4 + 2] * g4[2] * bflo(og.y), Hacc[4 * r4 + 3] * g4[3] * bfhi(og.y));
            *(LAS u32x2*)(yt + 16 * r4) = wv; }
    }
    __syncthreads();
    ML_YSTORE(NCHUNK - 1);
#undef ML_DMA
#undef ML_DMA_O
#undef ML_YSTORE
    __syncthreads();
}
__device__ __forceinline__ int queue_next(const Ctx& c, unsigned* head) {
    __syncthreads();
    if (c.tid == 0) *(volatile LAS unsigned*)(c.lds + QSLOT_OFF) = __hip_atomic_fetch_add(head, 1u, __ATOMIC_RELAXED, __HIP_MEMORY_SCOPE_AGENT);
    __syncthreads();
    return __builtin_amdgcn_readfirstlane((int)*(volatile LAS unsigned*)(c.lds + QSLOT_OFF));
}

__device__ __forceinline__ unsigned char* opq_ws(unsigned char* p) { asm volatile("" : "+s"(p)); return p; }
__device__ __forceinline__ bool fresh(Ctx& c) { const int t = opaque_tid(c.wave); c.tid = t; c.lane = t & 63;
    int w = blockIdx.x, n = gridDim.x; asm volatile("" : "+s"(w), "+s"(n)); c.wg = w; c.nwg = n; c.ng = (n % 16 == 0) ? 8 : 1; c.g = w % c.ng; return true; }
constexpr int PH_PRO = 1, PH_PER_LAYER = 8, PH_TOTAL = PH_PRO + NL * PH_PER_LAYER;
__global__ void __launch_bounds__(NTHREADS, 2) fwd(Args a) {
    extern __shared__ __attribute__((aligned(16))) unsigned char lds_raw[];
    Ctx c; c.lds = (LAS unsigned char*)lds_raw; c.tid = threadIdx.x; c.lane = c.tid & 63; c.wave = __builtin_amdgcn_readfirstlane(c.tid >> 6); c.wg = blockIdx.x; c.nwg = gridDim.x; c.ng = 1; c.g = 0;
    volatile LAS unsigned* MISC = (volatile LAS unsigned*)(c.lds + MISC_OFF);
    for (int u = c.tid; u < (LDS_BYTES - LDSCTL_OFF) / 4; u += NTHREADS) ((LAS unsigned*)(c.lds + LDSCTL_OFF))[u] = 0u;
    __syncthreads();
    XcdBarrier bar; bar.bar = (unsigned*)(a.ws + WS_CTL) + CW_BAR; bar.x = 0; bar.st = nullptr;
    if (N_LAUNCHES == 1) { bar = xcd_barrier_post((unsigned*)(a.ws + WS_CTL) + CW_BAR, MISC + 8);
        if (threadIdx.x == 0 && (gridDim.x % 16 != 0 || bar.x != blockIdx.x % 8)) (void)xb_add((unsigned*)(a.ws + WS_CTL) + CW_MIS, 1u); }
    const int lo = a.ph_lo, hi = a.ph_hi;
    bool xcd_local = false;
#define WS(off) (opq_ws(a.ws) + (off))
#define INP(i) ((const float*)in_ptr(a, (i)))
#define INL(i, stride) (INP(i) + (size_t)l * (stride))
#define XB ((bf16_t*)WS(WS_XB))
#define XSSQ ((float*)WS(WS_XSSQ))
#define GATES ((float*)WS(WS_GATES))
#define RSCQ ((float*)WS(WS_RSCQ))
#define RSCKV ((float*)WS(WS_RSCKV))
#define KR ((bf16_t*)WS(WS_KR))
#define MEMB ((bf16_t*)WS(WS_MEMB))
#define MEMSSQ ((float*)WS(WS_MEMSSQ))
#define KVX(l) ((bf16_t*)WS(WS_KVX) + (size_t)(l) * 1024)
#define GOFF(total_, flat_, ld_) ((size_t)c.g * ((size_t)(total_) / c.ng) + (size_t)(flat_) / c.ng - (size_t)c.g * (T / c.ng) * (ld_) * 2)
#define YMIX ((bf16_t*)WS(WS_YMIX))
#define UC ((bf16_t*)(WS(WS_YMIX) + GOFF(64 * MiB, 0, 512)))
#define PROJ ((bf16_t*)(WS(WS_PROJ) + GOFF(272 * MiB, 0, NPROJ)))
#define QKM ((bf16_t*)(WS(WS_PROJ) + GOFF(272 * MiB, 128 * MiB, 512)))
#define QA ((bf16_t*)(WS(WS_PROJ) + GOFF(272 * MiB, 160 * MiB, 768)))
#define KV ((bf16_t*)(WS(WS_PROJ) + GOFF(272 * MiB, 208 * MiB, 1024)))
#define QX ((bf16_t*)(WS(WS_PROJ) + GOFF(272 * MiB, 0, 512)))
#define OX ((bf16_t*)(WS(WS_PROJ) + GOFF(272 * MiB, 32 * MiB, 512)))
#define HFF ((bf16_t*)(WS(WS_PROJ) + GOFF(272 * MiB, 0, DFF)))
#define COSB ((float*)WS(WS_COS))
#define SINB ((float*)WS(WS_SIN))
#define WT(l, off) ((bf16_t*)(WS(WS_W) + (size_t)(l) * W_LAYER + (off)))

#define FGEMM(EpiT, Eobj, Aptr, lda_, Bptr, ldb_, M_, N_, K_) FGEMMP(EpiT, Eobj, Aptr, lda_, Bptr, ldb_, M_, N_, K_, 0)
#define FGEMMP(EpiT, Eobj, Aptr, lda_, Bptr, ldb_, M_, N_, K_, APN_) FGEMMR(EpiT, Eobj, Aptr, lda_, Bptr, ldb_, M_, N_, K_, APN_, 0, pg8::WGM)
#define FGEMMR(EpiT, Eobj, Aptr, lda_, Bptr, ldb_, M_, N_, K_, APN_, ROT_, WGM_) do { const pg8::Gemm g_{Aptr, Bptr, M_, N_, K_, lda_, ldb_, (size_t)(APN_)}; pg8::StaticOrder S_; S_.init(M_, N_, c.nwg, (c.wg + (ROT_)) % c.nwg, WGM_); \
        pg8::gemm_phase<EpiT, pg8::StaticOrder, true, true>(c.lds, g_, S_, Eobj, c.wave); } while (0)
    typedef pg8::EpiBf16S<0, 1> EpiN; typedef pg8::EpiBf16S<0, 3> EpiV; typedef pg8::EpiBf16S<1, 1> EpiF;
  for (int ph = lo; ph < hi; ++ph) {
    fresh(c);
    if (ph == 0) {
        constexpr int NI[10] = {1024, 96, 64, 512, 256, 512, 256, 2048, 2048, 32}, PER_LAYER = 6848;
        LAS float* scr = (LAS float*)(c.lds + c.wave * 16384);
        const int gw = c.wg * NWAVES + c.wave, NGW = c.nwg * NWAVES;
        for (int it0 = gw; it0 < NL * PER_LAYER; it0 += NGW) {
            const int l = it0 / PER_LAYER; int it = it0 % PER_LAYER, m = 0;
#pragma unroll
            for (int q = 0; q < 9; ++q) if (m == q && it >= NI[q]) { it -= NI[q]; m = q + 1; }
            WDesc d; d.kind = 0; d.row_off = 0; d.kcol0 = 0; d.g = nullptr;
            if (m == 0)      { d.W = INL(4, 1024 * IN_COLS); d.g = INL(3, 1024); d.Wt = WT(l, WO_IN); d.K = 1024; d.N = IN_COLS; d.Npad = NPROJ; d.kind = 1; d.ldw = 1024; }
            else if (m == 1) { d.W = INL(14, 256 * 768); d.g = INL(12, 256); d.Wt = WT(l, WO_UQ); d.K = 256; d.N = 768; d.Npad = 768; d.ldw = 256; }
            else if (m == 2) { d.W = INL(15, 128 * 1024); d.g = INL(13, 128); d.Wt = WT(l, WO_UKV); d.K = 128; d.N = 1024; d.Npad = 1024; d.kind = 2; d.ldw = 256; d.kcol0 = 128; }
            else if (m == 3) { d.W = INL(19, 1024 * 1024); d.Wt = WT(l, WO_OUT); d.K = 1024; d.N = 1024; d.Npad = 1024; d.ldw = 1024; }
            else if (m == 4) { d.W = INL(22, 1024 * 512); d.g = INL(20, 1024); d.Wt = WT(l, WO_QX); d.K = 1024; d.N = 512; d.Npad = 512; d.ldw = 1024; }
            else if (m == 5) { d.W = INL(23, 1024 * 1024); d.g = INL(21, 1024); d.Wt = (bf16_t*)WS(WS_WKVX) + (size_t)l * 1024 * 1024; d.K = 1024; d.N = 1024; d.Npad = 1024; d.ldw = 1024; }
            else if (m == 6) { d.W = INL(26, 512 * 1024); d.Wt = WT(l, WO_OX); d.K = 512; d.N = 1024; d.Npad = 1024; d.ldw = 512; }
            else if (m == 7) { d.W = INL(28, 1024 * 4096); d.g = INL(27, 1024); d.Wt = WT(l, WO_FF1); d.K = 1024; d.N = 4096; d.Npad = 4096; d.ldw = 1024; }
            else if (m == 8) { d.W = INL(29, 4096 * 1024); d.Wt = WT(l, WO_FF2); d.K = 4096; d.N = 1024; d.Npad = 1024; d.ldw = 4096; }
            else { const int sub = it >> 2, hh = sub >> 1, isk = sub & 1; it &= 3;
                   d.W = INL(isk ? 8 : 7, 4 * 8192) + hh * 8192; d.Wt = WT(l, WO_QK); d.K = 128; d.N = 64; d.Npad = 64; d.ldw = 256; d.row_off = hh * 128 + isk * 64; d.kcol0 = (hh & 1) * 128; }
            conv_item(scr, c.lane, d, it);
        }
        for (int l = 0; l < NL; ++l) {
            const size_t gt = (size_t)c.wg * NTHREADS + c.tid, GT = (size_t)c.nwg * NTHREADS;
            u32x4* zk = (u32x4*)WT(l, WO_UKV);
            for (size_t i = gt; i < 1024 * 16; i += GT) zk[(i >> 4) * 32 + (i & 15)] = (u32x4){0u, 0u, 0u, 0u};
            u32x4* zq = (u32x4*)WT(l, WO_QK);
            for (size_t i = gt; i < 512 * 16; i += GT) { const int row = (int)(i >> 4), chn = (int)(i & 15); zq[(size_t)row * 32 + ((((row >> 7) & 1) ^ 1) << 4) + chn] = (u32x4){0u, 0u, 0u, 0u}; }
        }
        rows_to_bf16_ssq(c, INP(0), XB, XSSQ, T);
        rows_to_bf16_ssq(c, INP(1), MEMB, MEMSSQ, TM);
        rope_tables(c, (const int*)INP(2), COSB, SINB);
    }
    else {
        const int l = (ph - PH_PRO) / PH_PER_LAYER, k = (ph - PH_PRO) % PH_PER_LAYER;
        if (k == 0 || k == 1 || k == 4) {
            const int ng = k == 1 ? (l == 0 ? 4 : 3) : 1;
            if (k == 1) {
                kr_prep(c, PROJ, INL(17, 192), COSB, SINB, (const float*)WS(WS_RSKR), KR);
                pg8::StaticOrder So; So.init(T, 512, c.nwg, c.wg); pg8::Unit uo;
                for (int ui = 0; So.next(ui, uo); ++ui) conv_slab(c, uo.pm, uo.pn, PROJ, INL(5, 4 * 512), INL(6, 512), UC);
                asm volatile("s_waitcnt vmcnt(0)" ::: "memory"); __syncthreads(); }
            for (int gi = 0; gi < ng; ++gi) {
                fresh(c);
                const int sel = k == 0 ? 0 : k == 4 ? 1 : 2 + gi;
                bf16_t* O_ = sel == 0 ? PROJ : sel == 1 ? QX : sel == 2 ? QKM : sel == 3 ? KV : sel == 4 ? QA : (bf16_t*)WS(WS_KVX);
                const bf16_t* A_ = sel <= 1 ? XB : sel == 2 ? UC : sel == 3 ? PROJ + PC_CKV : sel == 4 ? PROJ + PC_CQ : MEMB;
                const bf16_t* B_ = sel == 5 ? (bf16_t*)WS(WS_WKVX) : sel == 3 ? WT(l, WO_UKV) + 128 : WT(l, sel == 0 ? WO_IN : sel == 1 ? WO_QX : sel == 2 ? WO_QK : WO_UQ);
                const int N_ = sel == 0 ? NPROJ : sel == 1 ? 512 : sel == 2 ? 512 : sel == 3 ? 1024 : sel == 4 ? 768 : NL * 1024, K_ = (sel <= 1 || sel == 5) ? 1024 : sel == 3 ? 128 : 256, ldb__ = sel == 3 ? 256 : K_,
                          lda_ = (sel <= 1 || sel == 5) ? 1024 : sel == 2 ? 512 : NPROJ, M_ = sel == 5 ? TM : T;
                float* G_ = sel == 0 ? GATES : nullptr; const float* R_ = sel <= 1 ? XSSQ : sel == 3 ? RSCKV : sel == 4 ? RSCQ : MEMSSQ; const int rm_ = (sel <= 1 || sel == 5) ? 1 : sel == 2 ? 0 : sel == 3 ? 5 : 4;
                const float* HG_ = sel == 3 ? INL(17, 192) : sel == 5 ? INP(25) : nullptr;
                asm volatile("" : "+s"(O_), "+s"(A_), "+s"(B_), "+s"(G_), "+s"(R_), "+s"(HG_));
                const EpiV E{O_, N_, R_, G_, INL(9, 4), INL(10, 4), rm_, (float*)RSCQ, (float*)RSCKV, (float*)WS(WS_RSKR), HG_, 128, (LAS float*)(c.lds + 131072), (LAS float*)(c.lds + 143360)};
                FGEMMR(EpiV, E, A_, lda_, B_, ldb__, M_, N_, K_, sel == 2 ? 512 : 0, sel == 5 ? c.nwg / 2 : 0, sel == 5 ? 2 : pg8::WGM); }
            if (k == 4) {
                asm volatile("s_waitcnt vmcnt(0)" ::: "memory"); __syncthreads(); fresh(c);
                pg8::StaticOrder So; So.init(T, 512, c.nwg, c.wg); pg8::Unit uo;
                for (int ui = 0; So.next(ui, uo); ++ui)
                    for (int hh = 0; hh < 2; ++hh)
                        attn_block<128, false, false>(c, uo.pm >> 3, 2 * uo.pn + hh, uo.pm & 7, QX, 512, KVX(l), NL * 1024, nullptr, KVX(l) + 512, NL * 1024, NMEM, OX, 512, 0, nullptr, INL(24, 128), nullptr, nullptr, QSCALE_X); } }
        else if (k == 3 || k == 5 || k == 7) {
            const bf16_t* A_ = k == 3 ? YMIX : k == 5 ? OX : HFF; const int K_ = k == 3 ? 1024 : k == 5 ? 512 : DFF;
            const bf16_t* B_ = WT(l, k == 3 ? WO_OUT : k == 5 ? WO_OX : WO_FF2); float* of_ = (k == 7 && l == NL - 1) ? a.out : nullptr;
            asm volatile("" : "+s"(A_), "+s"(B_), "+s"(of_));
            const pg8::EpiResidB E{XB, XSSQ, of_}; FGEMM(pg8::EpiResidB, E, A_, K_, B_, K_, T, 1024, K_); }
        else if (k == 2) {
            int item = c.wg / c.ng;
            for (;; item = queue_next(c, (unsigned*)WS(WS_CTL) + CW_Q + 64 * (l * 8 + c.g)) + c.nwg / c.ng) { const int nbh = 64 / c.ng;
                if (item >= 9 * nbh) break;
                fresh(c);
                if (item < nbh) mlstm_unit(c, c.g * nbh + item, QKM, PROJ, GATES, INL(11, 512), YMIX);
                else { const int idx = item - nbh, qb = 7 - idx / nbh, bh = c.g * nbh + idx % nbh; attn_block<192, true, true>(c, bh >> 2, bh & 3, qb, QA, 768, KV, 1024, KR, KV + 512, 1024, SEQ, YMIX, D, 512, INL(18, 512), INL(16, 192), COSB, SINB, QSCALE_A); } }
            }
        else if (k == 6) { const EpiF E{HFF, DFF, XSSQ, nullptr, nullptr, nullptr, 1, nullptr, nullptr, nullptr, nullptr, 0, nullptr, (LAS float*)(c.lds + 143360)}; FGEMM(EpiF, E, XB, 1024, WT(l, WO_FF1), 1024, T, DFF, 1024); }
    }
    if (ph + 1 < hi) { xcd_barrier(bar, !xcd_local);
        if (ph == 0) xcd_local = __builtin_amdgcn_readfirstlane((int)xb_ld((unsigned*)WS(WS_CTL) + CW_MIS)) == 0; }
  }
}

extern "C" void kernel_launch(void* const* d_in, const int* in_sizes, int n_in, void* d_out, int out_size, void* d_ws, size_t ws_size, hipStream_t stream) {
    static int grid = 0;
    if (grid == 0) {
        int dev = 0, cus = 0, per_cu = 0;
        if (n_in != 30 || out_size != T * D || ws_size < WS_END) { fprintf(stderr, "kernel_launch: unexpected problem (n_in %d, out %d, ws %zu < %zu)\n", n_in, out_size, ws_size, (size_t)WS_END); grid = -1; return; }
        if (hipGetDevice(&dev) != hipSuccess || hipDeviceGetAttribute(&cus, hipDeviceAttributeMultiprocessorCount, dev) != hipSuccess) { fprintf(stderr, "kernel_launch: device query failed\n"); grid = -1; return; }
        if (hipFuncSetAttribute((const void*)fwd, hipFuncAttributeMaxDynamicSharedMemorySize, LDS_BYTES) != hipSuccess) { fprintf(stderr, "kernel_launch: hipFuncSetAttribute failed\n"); grid = -1; return; }
        if (hipOccupancyMaxActiveBlocksPerMultiprocessor(&per_cu, (const void*)fwd, NTHREADS, LDS_BYTES) != hipSuccess || per_cu < 1) { fprintf(stderr, "kernel_launch: occupancy query says %d blocks/CU\n", per_cu); }
        (void)hipGetLastError();
        grid = cus;
    }
    if (grid < 0) return;
    (void)hipMemsetAsync((char*)d_ws + WS_CTL, 0, CTL_ZERO_BYTES, stream);
    Args a{};
    for (int i = 0; i < 30; ++i) a.in[i] = d_in[i];
    a.out = (float*)d_out; a.ws = (unsigned char*)d_ws;
#ifdef PROBE_X
    a.ph_lo = 0; a.ph_hi = PROBE_X; hipLaunchKernelGGL(fwd, dim3(grid), dim3(NTHREADS), LDS_BYTES, stream, a);
    (void)hipMemsetAsync((char*)d_ws + WS_CTL, 0, CTL_ZERO_BYTES, stream);
#endif
    if (N_LAUNCHES == 1) { a.ph_lo = 0; a.ph_hi = PH_TOTAL; hipLaunchKernelGGL(fwd, dim3(grid), dim3(NTHREADS), LDS_BYTES, stream, a); }
    else for (int p = 0; p < PH_TOTAL; ++p) { a.ph_lo = p; a.ph_hi = p + 1; hipLaunchKernelGGL(fwd, dim3(grid), dim3(NTHREADS), LDS_BYTES, stream, a); }
}
```
